# Optimizing an MI355X kernel written in HIP

```python
import math
import jax, jax.numpy as jnp
from jax import lax
import numpy as np

D_MODEL = 2048
BATCH = 4
SEQ = 2048
DEPTH = 1

CTX_LEN = 256
GRID_W = 64
EPS = 1e-6
S5_WIDTH = D_MODEL // 2
S5_GROUP = 16
S5_GROUPS = S5_WIDTH // S5_GROUP
S5_STATE = 64
MLA_HEADS = 8
QK_NOPE = 128
QK_ROPE = 64
V_DIM = 128
Q_RANK = 512
KV_RANK = 256
ROPE_BASE = 10000.0
Q_BLOCK = 128
ATTN_SCALE = (QK_NOPE + QK_ROPE) ** -0.5
N_BRANCH = 2
D_FF = -(-8 * D_MODEL // (3 * 256)) * 256
IN_COLS = S5_WIDTH + Q_RANK + KV_RANK + QK_ROPE + N_BRANCH * D_MODEL

kernel_name = 'hybrid_s5_mla_dit_block'


def rmsnorm(x, g):
    xf = x.astype(jnp.float32)
    y = xf * lax.rsqrt(jnp.mean(xf * xf, axis=-1, keepdims=True) + EPS)
    return (y * g.astype(jnp.float32)).astype(x.dtype)


def ada(cvec, w_mod, b_mod):
    m = jax.nn.silu(cvec) @ w_mod + b_mod
    return m.reshape(m.shape[:-1] + (6, D_MODEL))


def rope2d_tables(n_tokens):
    rows = n_tokens // GRID_W
    row = jnp.repeat(jnp.arange(rows, dtype=jnp.float32), GRID_W)
    col = jnp.tile(jnp.arange(GRID_W, dtype=jnp.float32), rows)
    n_freq = QK_ROPE // 4
    inv = ROPE_BASE ** (-jnp.arange(n_freq, dtype=jnp.float32) / n_freq)
    ang = jnp.stack([row[:, None] * inv, col[:, None] * inv], axis=1)
    return jnp.cos(ang), jnp.sin(ang)


def apply_rope2d(x, cos, sin):
    xs = x.reshape(x.shape[:-1] + (2, 2, QK_ROPE // 4))
    x1, x2 = xs[..., 0, :], xs[..., 1, :]
    c = cos[None, :, None].astype(x.dtype)
    s = sin[None, :, None].astype(x.dtype)
    out = jnp.stack([x1 * c - x2 * s, x2 * c + x1 * s], axis=-2)
    return out.reshape(x.shape)


def split_in(h):
    o = S5_WIDTH
    u = h[..., :o]
    cq = h[..., o:o + Q_RANK]
    o += Q_RANK
    ckv = h[..., o:o + KV_RANK]
    o += KV_RANK
    kr = h[..., o:o + QK_ROPE]
    o += QK_ROPE
    return u, cq, ckv, kr, h[..., o:]


def s5_discretize(a_re, a_im, log_dt, b_re, b_im):
    f32 = jnp.float32
    dt = jnp.exp(log_dt.astype(f32))[:, None]
    lr, li = a_re.astype(f32), a_im.astype(f32)
    mag = jnp.exp(lr * dt)
    ab_re, ab_im = mag * jnp.cos(li * dt), mag * jnp.sin(li * dt)
    den = lr * lr + li * li
    nr, ni = ab_re - 1.0, ab_im
    co_re = (nr * lr + ni * li) / den
    co_im = (ni * lr - nr * li) / den
    br, bi = b_re.astype(f32), b_im.astype(f32)
    bb_re = co_re[..., None] * br - co_im[..., None] * bi
    bb_im = co_re[..., None] * bi + co_im[..., None] * br
    return ab_re, ab_im, bb_re, bb_im


def _ssm_combine(e1, e2):
    a1r, a1i, b1r, b1i = e1
    a2r, a2i, b2r, b2i = e2
    return (a2r * a1r - a2i * a1i, a2r * a1i + a2i * a1r,
            a2r * b1r - a2i * b1i + b2r, a2r * b1i + a2i * b1r + b2i)


def s5_scan(u, disc, h0, reverse):
    ab_re, ab_im, bb_re, bb_im = disc
    bu_re = jnp.einsum('blgp,gnp->blgn', u, bb_re)
    bu_im = jnp.einsum('blgp,gnp->blgn', u, bb_im)
    if h0 is not None:
        idx = -1 if reverse else 0
        h_re, h_im = h0
        bu_re = bu_re.at[:, idx].add(ab_re * h_re - ab_im * h_im)
        bu_im = bu_im.at[:, idx].add(ab_re * h_im + ab_im * h_re)
    a_re = jnp.broadcast_to(ab_re, bu_re.shape)
    a_im = jnp.broadcast_to(ab_im, bu_re.shape)
    _, _, h_re, h_im = lax.associative_scan(_ssm_combine, (a_re, a_im, bu_re, bu_im),
                                            reverse=reverse, axis=1)
    return h_re, h_im


def s5_readout(h, c_re, c_im):
    h_re, h_im = h
    return (jnp.einsum('blgn,gpn->blgp', h_re, c_re)
            - jnp.einsum('blgn,gpn->blgp', h_im, c_im))


def s5_mixer(u_ctx, u_lat, p, need_ctx_out):
    f32 = jnp.float32
    B, L = u_lat.shape[:2]
    Lc = u_ctx.shape[1]
    uc = u_ctx.astype(f32).reshape(B, Lc, S5_GROUPS, S5_GROUP)
    ul = u_lat.astype(f32).reshape(B, L, S5_GROUPS, S5_GROUP)
    d_skip = p['s5_d'].astype(f32)
    y_lat = d_skip * ul
    y_ctx = d_skip * uc if need_ctx_out else None
    for d, rev in enumerate((False, True)):
        disc = s5_discretize(p['s5_a_re'][d], p['s5_a_im'][d], p['s5_log_dt'][d],
                             p['s5_b_re'][d], p['s5_b_im'][d])
        c_re, c_im = p['s5_c_re'][d].astype(f32), p['s5_c_im'][d].astype(f32)
        hc = s5_scan(uc, disc, None, rev)
        last = 0 if rev else -1
        hl = s5_scan(ul, disc, (hc[0][:, last], hc[1][:, last]), rev)
        y_lat = y_lat + s5_readout(hl, c_re, c_im)
        if need_ctx_out:
            y_ctx = y_ctx + s5_readout(hc, c_re, c_im)
    y_lat = y_lat.reshape(B, L, S5_WIDTH).astype(u_lat.dtype)
    if need_ctx_out:
        y_ctx = y_ctx.reshape(B, Lc, S5_WIDTH).astype(u_ctx.dtype)
    return y_lat, y_ctx


def mla_qkv(cq, ckv, kr, p, rope):
    B, L = cq.shape[:2]
    q = (rmsnorm(cq, p['q_norm']) @ p['w_uq']).reshape(B, L, MLA_HEADS, QK_NOPE + QK_ROPE)
    kv = (rmsnorm(ckv, p['kv_norm']) @ p['w_ukv']).reshape(B, L, MLA_HEADS, QK_NOPE + V_DIM)
    q_nope, q_rope = q[..., :QK_NOPE], q[..., QK_NOPE:]
    k_nope, v = kv[..., :QK_NOPE], kv[..., QK_NOPE:]
    k_rope = kr[:, :, None, :]
    if rope is not None:
        cos, sin = rope
        q_rope = apply_rope2d(q_rope, cos, sin)
        k_rope = apply_rope2d(k_rope, cos, sin)
    q = jnp.concatenate([q_nope, q_rope], axis=-1)
    k = jnp.concatenate([k_nope, jnp.broadcast_to(k_rope, (B, L, MLA_HEADS, QK_ROPE))], axis=-1)
    return q, k, v


def attend(q, k, v):
    s = jnp.einsum('bqhd,bkhd->bhqk', q, k, preferred_element_type=jnp.float32) * ATTN_SCALE
    pr = jax.nn.softmax(s, axis=-1).astype(v.dtype)
    return jnp.einsum('bhqk,bkhd->bqhd', pr, v)


def blocked_attend(q, k, v):
    B, L, H, dk = q.shape
    nb = L // Q_BLOCK
    qb = q.reshape(B, nb, Q_BLOCK, H, dk).transpose(1, 0, 2, 3, 4)
    ob = lax.map(lambda qi: attend(qi, k, v), qb)
    return ob.transpose(1, 0, 2, 3, 4).reshape(B, L, H, v.shape[-1])


def merge_branches(y5, o_mla, gate_cols, p):
    z = jax.nn.gelu(y5)
    a, b = jnp.split(z @ p['w_glu'], 2, axis=-1)
    br_s5 = a * jax.nn.sigmoid(b)
    br_mla = o_mla.reshape(o_mla.shape[:2] + (MLA_HEADS * V_DIM,)) @ p['w_mla_o']
    g_s5, g_mla = jnp.split(jax.nn.sigmoid(gate_cols), 2, axis=-1)
    return (g_s5 * br_s5 + g_mla * br_mla) @ p['w_out']


def swiglu(h, p):
    a, b = jnp.split(h @ p['w_ffn_in'], 2, axis=-1)
    return (jax.nn.silu(a) * b) @ p['w_ffn_out']


def layer(x, xc, m_lat, m_ctx, cos, sin, p, need_ctx_out):
    sh1, sc1, g1, sh2, sc2, g2 = (m_lat[..., i, :] for i in range(6))
    csh1, csc1, cg1, csh2, csc2, cg2 = (m_ctx[..., i, :] for i in range(6))
    hl = (rmsnorm(x, p['norm1']) * (1.0 + sc1) + sh1) @ p['w_in']
    hc = (rmsnorm(xc, p['norm1']) * (1.0 + csc1) + csh1) @ p['w_in']
    ul, cql, ckvl, krl, gl = split_in(hl)
    uc, cqc, ckvc, krc, gc = split_in(hc)
    y5_lat, y5_ctx = s5_mixer(uc, ul, p, need_ctx_out)
    qc, kc, vc = mla_qkv(cqc, ckvc, krc, p, None)
    ql, kl, vl = mla_qkv(cql, ckvl, krl, p, (cos, sin))
    k_all = jnp.concatenate([kl, kc], axis=1)
    v_all = jnp.concatenate([vl, vc], axis=1)
    ol = blocked_attend(ql, k_all, v_all)
    x = x + g1 * merge_branches(y5_lat, ol, gl, p)
    x = x + g2 * swiglu(rmsnorm(x, p['norm2']) * (1.0 + sc2) + sh2, p)
    if need_ctx_out:
        oc = attend(qc, kc, vc)
        xc = xc + cg1 * merge_branches(y5_ctx, oc, gc, p)
        xc = xc + cg2 * swiglu(rmsnorm(xc, p['norm2']) * (1.0 + csc2) + csh2, p)
    return x, xc


def setup_inputs(seed: int = 0) -> dict:
    key = jax.random.key(seed)
    ks = jax.random.split(key, 32)
    f32 = jnp.float32

    def nrm(k, shape, scale):
        return jax.random.normal(k, shape, f32) * scale

    G, N, P = S5_GROUPS, S5_STATE, S5_GROUP
    n_idx = jnp.arange(N, dtype=f32)
    return {
        'x': nrm(ks[0], (BATCH, SEQ, D_MODEL), 1.0),
        'c': nrm(ks[1], (BATCH, D_MODEL), 1.0),
        'ctx': nrm(ks[2], (BATCH, CTX_LEN, D_MODEL), 1.0),
        'c_ctx': nrm(ks[3], (D_MODEL,), 1.0),
        'w_mod': nrm(ks[4], (DEPTH, D_MODEL, 6 * D_MODEL), 0.3 * D_MODEL ** -0.5),
        'b_mod': nrm(ks[5], (DEPTH, 6 * D_MODEL), 0.02),
        'norm1': 1.0 + nrm(ks[6], (DEPTH, D_MODEL), 0.01),
        'norm2': 1.0 + nrm(ks[7], (DEPTH, D_MODEL), 0.01),
        'w_in': nrm(ks[8], (DEPTH, D_MODEL, IN_COLS), D_MODEL ** -0.5),
        's5_a_re': -0.5 + nrm(ks[9], (DEPTH, 2, G, N), 0.01),
        's5_a_im': math.pi * n_idx + nrm(ks[10], (DEPTH, 2, G, N), 0.01),
        's5_log_dt': jax.random.uniform(ks[11], (DEPTH, 2, G), f32, math.log(1e-3), math.log(1e-1)),
        's5_b_re': nrm(ks[12], (DEPTH, 2, G, N, P), (2 * P) ** -0.5),
        's5_b_im': nrm(ks[13], (DEPTH, 2, G, N, P), (2 * P) ** -0.5),
        's5_c_re': nrm(ks[14], (DEPTH, 2, G, P, N), N ** -0.5),
        's5_c_im': nrm(ks[15], (DEPTH, 2, G, P, N), N ** -0.5),
        's5_d': nrm(ks[16], (DEPTH, G, P), 0.5),
        'w_glu': nrm(ks[17], (DEPTH, S5_WIDTH, 2 * D_MODEL), S5_WIDTH ** -0.5),
        'q_norm': 1.0 + nrm(ks[18], (DEPTH, Q_RANK), 0.01),
        'kv_norm': 1.0 + nrm(ks[19], (DEPTH, KV_RANK), 0.01),
        'w_uq': nrm(ks[20], (DEPTH, Q_RANK, MLA_HEADS * (QK_NOPE + QK_ROPE)), Q_RANK ** -0.5),
        'w_ukv': nrm(ks[21], (DEPTH, KV_RANK, MLA_HEADS * (QK_NOPE + V_DIM)), KV_RANK ** -0.5),
        'w_mla_o': nrm(ks[22], (DEPTH, MLA_HEADS * V_DIM, D_MODEL), (MLA_HEADS * V_DIM) ** -0.5),
        'w_out': nrm(ks[23], (DEPTH, D_MODEL, D_MODEL), D_MODEL ** -0.5),
        'w_ffn_in': nrm(ks[24], (DEPTH, D_MODEL, 2 * D_FF), D_MODEL ** -0.5),
        'w_ffn_out': nrm(ks[25], (DEPTH, D_FF, D_MODEL), D_FF ** -0.5),
        'norm_f': 1.0 + nrm(ks[26], (D_MODEL,), 0.01),
    }


def reference(x, c, ctx, c_ctx, w_mod, b_mod, norm1, norm2, w_in, s5_a_re, s5_a_im, s5_log_dt,
              s5_b_re, s5_b_im, s5_c_re, s5_c_im, s5_d, w_glu, q_norm, kv_norm, w_uq, w_ukv,
              w_mla_o, w_out, w_ffn_in, w_ffn_out, norm_f):
    cos, sin = rope2d_tables(x.shape[1])
    xc = ctx
    for l in range(DEPTH):
        p = {
            'norm1': norm1[l], 'norm2': norm2[l], 'w_in': w_in[l],
            's5_a_re': s5_a_re[l], 's5_a_im': s5_a_im[l], 's5_log_dt': s5_log_dt[l],
            's5_b_re': s5_b_re[l], 's5_b_im': s5_b_im[l], 's5_c_re': s5_c_re[l], 's5_c_im': s5_c_im[l],
            's5_d': s5_d[l], 'w_glu': w_glu[l], 'q_norm': q_norm[l], 'kv_norm': kv_norm[l],
            'w_uq': w_uq[l], 'w_ukv': w_ukv[l], 'w_mla_o': w_mla_o[l], 'w_out': w_out[l],
            'w_ffn_in': w_ffn_in[l], 'w_ffn_out': w_ffn_out[l],
        }
        m_lat = ada(c, w_mod[l], b_mod[l])[:, None]
        m_ctx = ada(c_ctx, w_mod[l], b_mod[l])
        x, xc = layer(x, xc, m_lat, m_ctx, cos, sin, p, l < DEPTH - 1)
    return rmsnorm(x, norm_f)
```

```cpp
#include <hip/hip_runtime.h>
#include <hip/hip_cooperative_groups.h>
#include <cstdio>
#include <cstdint>
namespace cg = cooperative_groups;
namespace pg8 {
#define PG8_LAS __attribute__((address_space(3)))
typedef unsigned short bf16_t;
typedef short bf16x8 __attribute__((ext_vector_type(8)));
typedef float f32x4 __attribute__((ext_vector_type(4)));
typedef unsigned u32x4 __attribute__((ext_vector_type(4)));
constexpr int BM = 256, BK = 64, HALF = 128, HTB = HALF * BK * 2  , STAGE_BYTES = 8 * HTB, NXCD = 8, WGM = 8;

__host__ __device__ __forceinline__ int lds_byte(int r, int c) { const int st = (r >> 4) * 2 + (c >> 5), rr = r & 15, cc = c & 31, ob = rr * 64 + cc * 2; return st * 1024 + (ob ^ (((ob >> 9) & 1) << 5)); }
__host__ __device__ __forceinline__ void stage_rc(int b, int& R, int& C) { const int st = b / 1024, sb = b % 1024, swz = sb ^ (((sb >> 9) & 1) << 5); R = (st >> 1) * 16 + swz / 64; C = (st & 1) * 32 + (swz % 64) / 2; }
__host__ __device__ __forceinline__ int perm32(int rho) { const int n = rho >> 4, i = rho & 15; return 8 * (i >> 2) + 4 * n + (i & 3); }

struct Unit { int pm, pn; };
struct Gemm { const bf16_t* A; const bf16_t* Bt; int M, N, K, lda, ldb; };

struct StaticOrder {
    int nM, nN, nwg, G, c;
    __host__ __device__ void init(int M, int N, int G_, int c_) { nM = M / BM; nN = N / BM; nwg = nM * nN; G = G_; c = c_; }
    __host__ __device__ bool next(int i, Unit& u) const {
        const long L = (long)i * G + c; if (L >= nwg) return false;
        int wgid = (int)L; { const int q = nwg / NXCD, r = nwg % NXCD, xcd = wgid % NXCD, off = wgid / NXCD; wgid = (xcd < r ? xcd * (q + 1) : r * (q + 1) + (xcd - r) * q) + off; }
        const int nig = WGM * nN, gid = wgid / nig, fm = gid * WGM, gsz = (nM - fm) < WGM ? (nM - fm) : WGM;
        u.pm = fm + ((wgid % nig) % gsz); u.pn = (wgid % nig) / gsz; return true;
    }
    __device__ __forceinline__ void a_ready(const Unit&) const {}
    __device__ __forceinline__ void done(const Unit&) const {}
};


typedef float f32x2_t __attribute__((ext_vector_type(2))); typedef __bf16 bf16x2_t __attribute__((ext_vector_type(2)));
__device__ __forceinline__ unsigned cvtpk(float lo, float hi) { f32x2_t v = {lo, hi}; bf16x2_t b = __builtin_convertvector(v, bf16x2_t); return __builtin_bit_cast(unsigned, b); }
__device__ __forceinline__ u32x4 pack8(f32x4 a, f32x4 b) { u32x4 w; w.x = cvtpk(a[0], a[1]); w.y = cvtpk(a[2], a[3]); w.z = cvtpk(b[0], b[1]); w.w = cvtpk(b[2], b[3]); return w; }
__device__ __forceinline__ void unpack8(u32x4 w, f32x4& a, f32x4& b) {
    a[0] = __uint_as_float(w.x << 16); a[1] = __uint_as_float(w.x & 0xffff0000u); a[2] = __uint_as_float(w.y << 16); a[3] = __uint_as_float(w.y & 0xffff0000u);
    b[0] = __uint_as_float(w.z << 16); b[1] = __uint_as_float(w.z & 0xffff0000u); b[2] = __uint_as_float(w.w << 16); b[3] = __uint_as_float(w.w & 0xffff0000u); }
__device__ __forceinline__ float sigm(float x) { return __builtin_amdgcn_rcpf(1.f + __builtin_amdgcn_exp2f(-1.4426950408889634f * x)); }
__device__ __forceinline__ f32x4 sigm4(f32x4 v) { f32x4 o; o[0] = sigm(v[0]); o[1] = sigm(v[1]); o[2] = sigm(v[2]); o[3] = sigm(v[3]); return o; }
__device__ __forceinline__ float rowred(float s) { s += __shfl_xor(s, 16); s += __shfl_xor(s, 32); return s; }
__device__ __forceinline__ float dot4(f32x4 x) { return (x[0] * x[0] + x[1] * x[1]) + (x[2] * x[2] + x[3] * x[3]); }
__device__ __forceinline__ void rope4(f32x4& v0, f32x4& v1, int pos, int fq) {
#pragma unroll
    for (int i = 0; i < 4; ++i) { const float f = (float)(4 * fq + i); const float inv = __builtin_amdgcn_exp2f(-f * 0.8304820237218406f);
        const float rev = (float)pos * inv * 0.15915494309189535f; const float c = __builtin_amdgcn_cosf(rev), s = __builtin_amdgcn_sinf(rev);
        const float a = v0[i], b = v1[i]; v0[i] = a * c - b * s; v1[i] = b * c + a * s; }
}
#define LDNT4(p) __builtin_nontemporal_load((const f32x4*)(p))
#define LDNT16(p) __builtin_nontemporal_load((const u32x4*)(p))
#define EPI_ARGS f32x4 (&acc)[2][2][4][2], const Unit& u, int wr, int wc, int fr, int fq
#define EPI_ROWS _Pragma("unroll") for (int ai = 0; ai < 2; ++ai) _Pragma("unroll") for (int m = 0; m < 4; ++m)
constexpr float EPSN = 1e-6f;

struct EpiIn { static constexpr bool PERM = true, AFTER_DRAIN = false;
    bf16_t *U, *CQKV, *KR, *GATES; float *ssq_q, *ssq_kv;
    __device__ __forceinline__ void operator()(EPI_ARGS) const {
        const int pn = u.pn, row0 = u.pm * BM + wr * 64 + fr, cl = wc * 32 + 8 * fq;
        if (pn < 4) {
            EPI_ROWS { const int row = row0 + ai * HALF + m * 16;
#pragma unroll
                for (int bj = 0; bj < 2; ++bj) *(u32x4*)(U + (size_t)row * 1024 + pn * 256 + bj * HALF + cl) = pack8(acc[ai][bj][m][0], acc[ai][bj][m][1]); }
        } else if (pn < 7) {
            float* ssq = pn < 6 ? ssq_q : ssq_kv;
            EPI_ROWS { const int row = row0 + ai * HALF + m * 16; float s = 0.f;
#pragma unroll
                for (int bj = 0; bj < 2; ++bj) { s += dot4(acc[ai][bj][m][0]) + dot4(acc[ai][bj][m][1]);
                    *(u32x4*)(CQKV + (size_t)row * 768 + (pn - 4) * 256 + bj * HALF + cl) = pack8(acc[ai][bj][m][0], acc[ai][bj][m][1]); }
                s = rowred(s); if (fq == 0) atomicAdd(ssq + row, s); }
        } else if (pn == 7) {
            if (wc < 2) {
                EPI_ROWS { const int row = row0 + ai * HALF + m * 16; f32x4 v0 = acc[ai][0][m][0], v1 = acc[ai][0][m][1];
                    if (u.pm < 32) { const int l = row & 2047; rope4(v0, v1, wc == 0 ? (l >> 6) : (l & 63), fq); }
                    *(u32x4*)(KR + (size_t)row * 64 + cl) = pack8(v0, v1); }
            }
        } else if (u.pm < 32) {
            EPI_ROWS { const int row = row0 + ai * HALF + m * 16;
#pragma unroll
                for (int bj = 0; bj < 2; ++bj) *(u32x4*)(GATES + (size_t)row * 4096 + (pn - 8) * 256 + bj * HALF + cl) = pack8(sigm4(acc[ai][bj][m][0]), sigm4(acc[ai][bj][m][1])); }
        }
    }
};
struct EpiQ { static constexpr bool PERM = true, AFTER_DRAIN = false;
    bf16_t* Q; const float* ssq_q;
    __device__ __forceinline__ void operator()(EPI_ARGS) const {
        const int row0 = u.pm * BM + wr * 64 + fr;
        EPI_ROWS { const int row = row0 + ai * HALF + m * 16; const float rstd = __builtin_amdgcn_rsqf(ssq_q[row] * (1.f / 512.f) + EPSN); const int l = row & 2047;
#pragma unroll
            for (int bj = 0; bj < 2; ++bj) { const int colg = u.pn * BM + bj * HALF + wc * 32, off = colg % 192; f32x4 v0 = acc[ai][bj][m][0] * rstd, v1 = acc[ai][bj][m][1] * rstd;
                if (off >= 128) rope4(v0, v1, off < 160 ? (l >> 6) : (l & 63), fq);
                *(u32x4*)(Q + (size_t)row * 1536 + colg + 8 * fq) = pack8(v0, v1); } }
    }
};
struct EpiKV { static constexpr bool PERM = true, AFTER_DRAIN = false;
    bf16_t *KN, *V; const float* ssq_kv;
    __device__ __forceinline__ void operator()(EPI_ARGS) const {
        const int row0 = u.pm * BM + wr * 64 + fr, cl = wc * 32 + 8 * fq;
        EPI_ROWS { const int row = row0 + ai * HALF + m * 16; const float rstd = __builtin_amdgcn_rsqf(ssq_kv[row] * (1.f / 256.f) + EPSN);
            *(u32x4*)(KN + (size_t)row * 1024 + u.pn * 128 + cl) = pack8(acc[ai][0][m][0] * rstd, acc[ai][0][m][1] * rstd);
            *(u32x4*)(V + (size_t)row * 1024 + u.pn * 128 + cl) = pack8(acc[ai][1][m][0] * rstd, acc[ai][1][m][1] * rstd); }
    }
};
struct EpiGlu { static constexpr bool PERM = true, AFTER_DRAIN = false;
    bf16_t* S5P; const bf16_t* GATES;
    __device__ __forceinline__ void operator()(EPI_ARGS) const {
        const int row0 = u.pm * BM + wr * 64 + fr, c = u.pn * 128 + wc * 32 + 8 * fq;
        EPI_ROWS { const int row = row0 + ai * HALF + m * 16; f32x4 g0, g1; unpack8(LDNT16(GATES + (size_t)row * 4096 + c), g0, g1);
            *(u32x4*)(S5P + (size_t)row * 2048 + c) = pack8(g0 * acc[ai][0][m][0] * sigm4(acc[ai][1][m][0]), g1 * acc[ai][0][m][1] * sigm4(acc[ai][1][m][1])); }
    }
};
struct EpiMix { static constexpr bool PERM = true, AFTER_DRAIN = false;
    const bf16_t *S5P, *GATES; bf16_t* MIX;
    __device__ __forceinline__ void operator()(EPI_ARGS) const {
        const int row0 = u.pm * BM + wr * 64 + fr;
        EPI_ROWS { const int row = row0 + ai * HALF + m * 16;
#pragma unroll
            for (int bj = 0; bj < 2; ++bj) { const int c = u.pn * BM + bj * HALF + wc * 32 + 8 * fq; f32x4 g0, g1, s0, s1;
                unpack8(LDNT16(GATES + (size_t)row * 4096 + 2048 + c), g0, g1); unpack8(LDNT16(S5P + (size_t)row * 2048 + c), s0, s1);
                *(u32x4*)(MIX + (size_t)row * 2048 + c) = pack8(s0 + g0 * acc[ai][bj][m][0], s1 + g1 * acc[ai][bj][m][1]); } }
    }
};
struct EpiOut { static constexpr bool PERM = true, AFTER_DRAIN = false;
    const float *x, *MOD, *norm2; float *X1, *ssq; bf16_t* X1S;
    __device__ __forceinline__ void operator()(EPI_ARGS) const {
        const int row0 = u.pm * BM + wr * 64 + fr; const float* mod = MOD + (size_t)(u.pm >> 3) * 12288;
        EPI_ROWS { const int row = row0 + ai * HALF + m * 16; float s = 0.f;
#pragma unroll
            for (int bj = 0; bj < 2; ++bj) { const int c = u.pn * BM + bj * HALF + wc * 32 + 8 * fq; const size_t o = (size_t)row * 2048 + c;
                f32x4 x1v[2];
#pragma unroll
                for (int n = 0; n < 2; ++n) { const f32x4 g1 = *(const f32x4*)(mod + 2 * 2048 + c + 4 * n), xv = LDNT4(x + o + 4 * n);
                    x1v[n] = xv + g1 * acc[ai][bj][m][n]; *(f32x4*)(X1 + o + 4 * n) = x1v[n]; s += dot4(x1v[n]); }
                const f32x4 sa = *(const f32x4*)(norm2 + c) * (*(const f32x4*)(mod + 4 * 2048 + c) + 1.f), sb = *(const f32x4*)(norm2 + c + 4) * (*(const f32x4*)(mod + 4 * 2048 + c + 4) + 1.f);
                *(u32x4*)(X1S + o) = pack8(x1v[0] * sa, x1v[1] * sb); }
            s = rowred(s); if (fq == 0) atomicAdd(ssq + row, s); }
    }
};
struct EpiFfn1 { static constexpr bool PERM = true, AFTER_DRAIN = false;
    const float *ssq, *BIAS2; bf16_t* ACT;
    __device__ __forceinline__ void operator()(EPI_ARGS) const {
        const int row0 = u.pm * BM + wr * 64 + fr, cb = u.pn * BM + wc * 32 + 8 * fq; const float* bias = BIAS2 + (size_t)(u.pm >> 3) * 11264 + cb;
        const f32x4 ba0 = *(const f32x4*)(bias), ba1 = *(const f32x4*)(bias + 4), bb0 = *(const f32x4*)(bias + HALF), bb1 = *(const f32x4*)(bias + HALF + 4);
        EPI_ROWS { const int row = row0 + ai * HALF + m * 16; const float rstd = __builtin_amdgcn_rsqf(ssq[row] * (1.f / 2048.f) + EPSN);
            const f32x4 a0 = acc[ai][0][m][0] * rstd + ba0, a1 = acc[ai][0][m][1] * rstd + ba1, b0 = acc[ai][1][m][0] * rstd + bb0, b1 = acc[ai][1][m][1] * rstd + bb1;
            *(u32x4*)(ACT + (size_t)row * 5632 + u.pn * 128 + wc * 32 + 8 * fq) = pack8(a0 * sigm4(a0) * b0, a1 * sigm4(a1) * b1); }
    }
};
struct EpiFfn2 { static constexpr bool PERM = true, AFTER_DRAIN = false;
    const float *X1, *MOD, *normf; float *out, *ssq; unsigned* cnt; int fuse;
    __device__ __forceinline__ void operator()(EPI_ARGS) const {
        const int row0 = u.pm * BM + wr * 64 + fr; const float* mod = MOD + (size_t)(u.pm >> 3) * 12288 + 5 * 2048;
        EPI_ROWS { const int row = row0 + ai * HALF + m * 16; float s = 0.f;
#pragma unroll
            for (int bj = 0; bj < 2; ++bj) { const int c = u.pn * BM + bj * HALF + wc * 32 + 8 * fq; const size_t o = (size_t)row * 2048 + c;
#pragma unroll
                for (int n = 0; n < 2; ++n) { const f32x4 x2 = LDNT4(X1 + o + 4 * n) + *(const f32x4*)(mod + c + 4 * n) * acc[ai][bj][m][n]; acc[ai][bj][m][n] = x2; if (!fuse) *(f32x4*)(out + o + 4 * n) = x2; s += dot4(x2); } }
            s = rowred(s); if (fq == 0) atomicAdd(ssq + row, s); }
        if (!fuse) return;
        asm volatile("s_waitcnt vmcnt(0)" ::: "memory");
        unsigned* pc = cnt + 64 * u.pm;
        if ((threadIdx.x & 63) == 0) __hip_atomic_fetch_add(pc, 1u, __ATOMIC_RELAXED, __HIP_MEMORY_SCOPE_AGENT);
        if (threadIdx.x < 64) { unsigned sp = 0; while ((unsigned)__builtin_amdgcn_readfirstlane(__hip_atomic_load(pc, __ATOMIC_RELAXED, __HIP_MEMORY_SCOPE_AGENT)) < 64u) { __builtin_amdgcn_s_sleep(2); if (++sp > (1u << 20)) break; } }
        __builtin_amdgcn_fence(__ATOMIC_ACQUIRE, "agent");
        __syncthreads();
        EPI_ROWS { const int row = row0 + ai * HALF + m * 16; const float rstd = __builtin_amdgcn_rsqf(__hip_atomic_load(ssq + row, __ATOMIC_RELAXED, __HIP_MEMORY_SCOPE_AGENT) * (1.f / 2048.f) + EPSN);
#pragma unroll
            for (int bj = 0; bj < 2; ++bj) { const int c = u.pn * BM + bj * HALF + wc * 32 + 8 * fq; const size_t o = (size_t)row * 2048 + c;
#pragma unroll
                for (int n = 0; n < 2; ++n) *(f32x4*)(out + o + 4 * n) = acc[ai][bj][m][n] * rstd * *(const f32x4*)(normf + c + 4 * n); } }
    }
};

template <class Epi, class Sched, bool ALIGN_EPI = false, bool SP2 = false>
__device__ __forceinline__ void gemm_phase(PG8_LAS unsigned char* lds, const Gemm g, const Sched& S, const Epi& E) {
    int tid_o = threadIdx.x; asm volatile("" : "+v"(tid_o));
    const int tid = tid_o, wid = __builtin_amdgcn_readfirstlane(tid >> 6), lane = tid & 63, wr = wid >> 2, wc = wid & 3, fr = lane & 15, fq = lane >> 4;
    const int K = g.K, nt = K / BK;
    unsigned voffA[2], voffB[2];
#pragma unroll
    for (int i = 0; i < 2; ++i) { int R, C; stage_rc(tid * 16 + i * 8192, R, C); const int Rb = Epi::PERM ? ((R & ~31) + perm32(R & 31)) : R;
        voffA[i] = (unsigned)(R * g.lda + C) * 2u; voffB[i] = (unsigned)(Rb * g.ldb + C) * 2u; }
    const size_t kstep = (size_t)(BK * 2);
    const size_t hstepA = (size_t)HALF * g.lda * 2, hstepB = (size_t)HALF * g.ldb * 2;
    const size_t tstepA = 2 * hstepA, tstepB = 2 * hstepB;
    const unsigned ldsw = (unsigned)wid * 1024u;
    const int aoff = lds_byte(wr * 64 + fr, fq * 8), boff = lds_byte(wc * 32 + fr, fq * 8);
#define PG8_SA(b, h) (((b) * 2 + (h)) * HTB)
#define PG8_SB(b, h) ((4 + (b) * 2 + (h)) * HTB)
#define PG8_STAGE(bufoff, gbase, voff) do { _Pragma("unroll") for (int _i = 0; _i < 2; ++_i) \
        __builtin_amdgcn_global_load_lds((const unsigned*)((const char*)(gbase) + (voff)[_i]), (PG8_LAS unsigned*)(lds + (bufoff) + ldsw + _i * 8192), 16, 0, 0); } while (0)
#define PG8_LDA(dst, b, h) do { _Pragma("unroll") for (int m = 0; m < 4; ++m) _Pragma("unroll") for (int k = 0; k < 2; ++k) dst[m][k] = *(const PG8_LAS bf16x8*)(lds + PG8_SA(b, h) + aoff + m * 2048 + k * 1024); } while (0)
#define PG8_LDB(dst, b, h) do { _Pragma("unroll") for (int n = 0; n < 2; ++n) _Pragma("unroll") for (int k = 0; k < 2; ++k) dst[n][k] = *(const PG8_LAS bf16x8*)(lds + PG8_SB(b, h) + boff + n * 2048 + k * 1024); } while (0)
#define PG8_MMA(ai, bj, At, Bt) do { __builtin_amdgcn_s_setprio(1); _Pragma("unroll") for (int m = 0; m < 4; ++m) _Pragma("unroll") for (int n = 0; n < 2; ++n) _Pragma("unroll") for (int k = 0; k < 2; ++k) \
        acc[ai][bj][m][n] = __builtin_amdgcn_mfma_f32_16x16x32_bf16(Bt[n][k], At[m][k], acc[ai][bj][m][n], 0, 0, 0); __builtin_amdgcn_s_setprio(0); } while (0)
#define PG8_WAIT_V(n) asm volatile("s_waitcnt vmcnt(" #n ")" ::: "memory")
#define PG8_WAIT_L(n) asm volatile("s_waitcnt lgkmcnt(" #n ")" ::: "memory")
#define PG8_BAR __builtin_amdgcn_s_barrier()
#define PG8_SCHED __builtin_amdgcn_sched_barrier(0)
    Unit cur, nxt; int ui = 0;
    if (!S.next(0, cur)) return;
    f32x4 acc[2][2][4][2];
#pragma unroll
    for (int a = 0; a < 2; ++a)
#pragma unroll
        for (int b = 0; b < 2; ++b)
#pragma unroll
            for (int m = 0; m < 4; ++m)
#pragma unroll
                for (int n = 0; n < 2; ++n) acc[a][b][m][n] = (f32x4){0.f, 0.f, 0.f, 0.f};
    bf16x8 At[4][2], B0[2][2], B1[2][2];
    const char* cA = (const char*)g.A + (size_t)cur.pm * tstepA; const char* cB = (const char*)g.Bt + (size_t)cur.pn * tstepB;
    S.a_ready(cur);
    if constexpr (SP2) {
        PG8_STAGE(PG8_SB(0, 0), cB, voffB); PG8_STAGE(PG8_SB(0, 1), cB + hstepB, voffB); PG8_STAGE(PG8_SA(0, 0), cA, voffA); PG8_STAGE(PG8_SA(0, 1), cA + hstepA, voffA);
        if (wr == 1) PG8_BAR;
        PG8_WAIT_V(2); PG8_BAR;
        PG8_STAGE(PG8_SB(1, 0), cB + kstep, voffB); PG8_STAGE(PG8_SA(1, 0), cA + kstep, voffA); PG8_STAGE(PG8_SB(1, 1), cB + hstepB + kstep, voffB);
        PG8_WAIT_V(6); PG8_BAR;
    } else {
        PG8_STAGE(PG8_SB(0, 0), cB, voffB); PG8_STAGE(PG8_SA(0, 0), cA, voffA); PG8_STAGE(PG8_SB(0, 1), cB + hstepB, voffB); PG8_STAGE(PG8_SA(0, 1), cA + hstepA, voffA);
        if (wr == 1) PG8_BAR;
        PG8_WAIT_V(4); PG8_BAR;
        PG8_STAGE(PG8_SB(1, 0), cB + kstep, voffB); PG8_STAGE(PG8_SA(1, 0), cA + kstep, voffA); PG8_STAGE(PG8_SB(1, 1), cB + hstepB + kstep, voffB);
        PG8_WAIT_V(6); PG8_BAR;
    }
    for (;;) {
        const bool has_next = S.next(ui + 1, nxt);
        const char* nA = has_next ? (const char*)g.A + (size_t)nxt.pm * tstepA : cA; const char* nB = has_next ? (const char*)g.Bt + (size_t)nxt.pn * tstepB : cB;
        for (int t = 0; t < nt; t += 2) {
            const bool last = (t == nt - 2);
            const char* a1 = cA + (size_t)(t + 1) * kstep;
            const char* a2 = last ? nA : cA + (size_t)(t + 2) * kstep; const char* b2 = last ? nB : cB + (size_t)(t + 2) * kstep;
            const char* a3 = a2 + kstep; const char* b3 = b2 + kstep;
            if (last && has_next) S.a_ready(nxt);
            if constexpr (SP2) {
            PG8_LDB(B0, 0, 0); PG8_LDB(B1, 0, 1); PG8_SCHED; PG8_LDA(At, 0, 0); PG8_STAGE(PG8_SA(1, 1), a1 + hstepA, voffA);
            PG8_WAIT_V(8); PG8_WAIT_L(0); PG8_BAR; PG8_MMA(0, 0, At, B0); PG8_MMA(0, 1, At, B1); PG8_BAR; PG8_SCHED;
            PG8_LDA(At, 0, 1); PG8_STAGE(PG8_SB(0, 0), b2, voffB); PG8_STAGE(PG8_SB(0, 1), b2 + hstepB, voffB); PG8_STAGE(PG8_SA(0, 0), a2, voffA);
            PG8_WAIT_V(8); PG8_WAIT_L(0); PG8_BAR; PG8_MMA(1, 0, At, B0); PG8_MMA(1, 1, At, B1); PG8_BAR; PG8_SCHED;
            PG8_LDB(B0, 1, 0); PG8_LDB(B1, 1, 1); PG8_SCHED; PG8_LDA(At, 1, 0); PG8_STAGE(PG8_SA(0, 1), a2 + hstepA, voffA);
            PG8_WAIT_V(8); PG8_WAIT_L(0); PG8_BAR; PG8_MMA(0, 0, At, B0); PG8_MMA(0, 1, At, B1); PG8_BAR; PG8_SCHED;
            PG8_LDA(At, 1, 1); PG8_STAGE(PG8_SB(1, 0), b3, voffB); PG8_STAGE(PG8_SB(1, 1), b3 + hstepB, voffB); PG8_STAGE(PG8_SA(1, 0), a3, voffA);
            PG8_WAIT_V(8); PG8_WAIT_L(0); PG8_BAR; PG8_MMA(1, 0, At, B0); PG8_MMA(1, 1, At, B1); PG8_BAR; PG8_SCHED;
            } else {
            PG8_LDB(B0, 0, 0); PG8_SCHED; PG8_LDA(At, 0, 0); PG8_STAGE(PG8_SA(1, 1), a1 + hstepA, voffA);
            PG8_WAIT_L(8); PG8_BAR; PG8_WAIT_L(0); PG8_MMA(0, 0, At, B0); PG8_BAR; PG8_SCHED;
            PG8_LDB(B1, 0, 1); PG8_STAGE(PG8_SB(0, 0), b2, voffB);
            PG8_BAR; PG8_WAIT_L(0); PG8_MMA(0, 1, At, B1); PG8_BAR;
            PG8_LDA(At, 0, 1); PG8_STAGE(PG8_SA(0, 0), a2, voffA);
            PG8_BAR; PG8_WAIT_L(0); PG8_MMA(1, 0, At, B0); PG8_BAR; PG8_SCHED;
            PG8_STAGE(PG8_SB(0, 1), b2 + hstepB, voffB);
            PG8_WAIT_V(6); PG8_BAR; PG8_MMA(1, 1, At, B1); PG8_BAR;
            PG8_LDB(B0, 1, 0); PG8_SCHED; PG8_LDA(At, 1, 0); PG8_STAGE(PG8_SA(0, 1), a2 + hstepA, voffA);
            PG8_WAIT_L(8); PG8_BAR; PG8_WAIT_L(0); PG8_MMA(0, 0, At, B0); PG8_BAR; PG8_SCHED;
            PG8_LDB(B1, 1, 1); PG8_STAGE(PG8_SB(1, 0), b3, voffB);
            PG8_BAR; PG8_WAIT_L(0); PG8_MMA(0, 1, At, B1); PG8_BAR;
            PG8_LDA(At, 1, 1); PG8_STAGE(PG8_SA(1, 0), a3, voffA);
            PG8_BAR; PG8_WAIT_L(0); PG8_MMA(1, 0, At, B0); PG8_BAR; PG8_SCHED;
            PG8_STAGE(PG8_SB(1, 1), b3 + hstepB, voffB);
            PG8_WAIT_V(6); PG8_BAR; PG8_MMA(1, 1, At, B1); PG8_BAR;
            }
        }
        if constexpr (ALIGN_EPI) { if (wr == 0) PG8_BAR; }
        if constexpr (!Epi::AFTER_DRAIN) { E(acc, cur, wr, wc, fr, fq); S.done(cur); }
        if (!has_next) break;
#pragma unroll
        for (int a = 0; a < 2; ++a)
#pragma unroll
            for (int b = 0; b < 2; ++b)
#pragma unroll
                for (int m = 0; m < 4; ++m)
#pragma unroll
                    for (int n = 0; n < 2; ++n) acc[a][b][m][n] = (f32x4){0.f, 0.f, 0.f, 0.f};
        cur = nxt; cA = nA; cB = nB; ++ui;
        if constexpr (ALIGN_EPI) { if (wr == 1) PG8_BAR; }
    }
    PG8_WAIT_V(0);
    if constexpr (!ALIGN_EPI) { if (wr == 0) PG8_BAR; }
    PG8_BAR;
    if constexpr (Epi::AFTER_DRAIN) { E.fused(acc, cur, wr, wc, fr, fq, lds, wid, lane); S.done(cur); }
#undef PG8_SA
#undef PG8_SB
#undef PG8_STAGE
#undef PG8_LDA
#undef PG8_LDB
#undef PG8_MMA
#undef PG8_WAIT_V
#undef PG8_WAIT_L
#undef PG8_BAR
#undef PG8_SCHED
}
}


#define LAS __attribute__((address_space(3)))
typedef unsigned short bf16_t;
typedef short bf16x8 __attribute__((ext_vector_type(8)));
typedef short s16x4 __attribute__((ext_vector_type(4)));
typedef float f32x4 __attribute__((ext_vector_type(4)));
typedef float f32x16 __attribute__((ext_vector_type(16)));
typedef unsigned u32x4 __attribute__((ext_vector_type(4)));
typedef unsigned u32x2 __attribute__((ext_vector_type(2)));
using pg8::cvtpk; using pg8::pack8; using pg8::unpack8; using pg8::sigm; using pg8::dot4;
#define LDS_WAIT() asm volatile("s_waitcnt lgkmcnt(0)" ::: "memory")
__device__ __forceinline__ int opaque_tid() { int t = threadIdx.x; asm volatile("" : "+v"(t)); return t; }

constexpr size_t MiB = 1u << 20;
constexpr size_t WS_CTL = 0, CTL_BYTES = 1 * MiB;
constexpr size_t WS_MOD = 1 * MiB, WS_BIAS2 = 1 * MiB + 512 * 1024;
constexpr size_t WS_WIN = 2 * MiB, WS_WGLU = 26 * MiB, WS_WUQ = 34 * MiB, WS_WUKV = 36 * MiB, WS_WMO = 38 * MiB, WS_WOUT = 42 * MiB, WS_WF1 = 50 * MiB, WS_WF2 = 94 * MiB;
constexpr size_t WS_GATES = 116 * MiB, WS_XMOD = 180 * MiB, WS_U = 216 * MiB, WS_CQKV = 234 * MiB, WS_KR = 248 * MiB, WS_KCOMB = 250 * MiB, WS_WTAB = 252 * MiB, WS_VTAB = 268 * MiB;
constexpr size_t WS_Q = 284 * MiB, WS_KN = 308 * MiB, WS_V = 326 * MiB, WS_Z = 344 * MiB;
constexpr size_t WS_O = 180 * MiB, WS_S5P = 216 * MiB, WS_MIX = 252 * MiB, WS_X1 = 284 * MiB, WS_X1S = 204 * MiB, WS_ACT = 116 * MiB;
constexpr size_t WS_END = 360 * MiB;
constexpr int SSQ_Q = 0, SSQ_KV = 16384, SSQ_1 = 32768, SSQ_2 = 49152;
constexpr int LDS_BYTES = 147456;

struct Params { const float* in[27]; float* out; unsigned char* ws; };
enum { I_X = 0, I_C, I_CTX, I_CCTX, I_WMOD, I_BMOD, I_NORM1, I_NORM2, I_WIN, I_ARE, I_AIM, I_LOGDT, I_BRE, I_BIM, I_CRE, I_CIM, I_D, I_WGLU, I_QNORM, I_KVNORM, I_WUQ, I_WUKV, I_WMO, I_WOUT, I_WF1, I_WF2, I_NORMF };

__device__ __forceinline__ float wave_sum(float v) {
#pragma unroll
    for (int o = 1; o < 64; o <<= 1) v += __shfl_xor(v, o);
    return v;
}
__device__ __forceinline__ float dot4m(f32x4 a, f32x4 b) { return (a[0] * b[0] + a[1] * b[1]) + (a[2] * b[2] + a[3] * b[3]); }
__device__ __forceinline__ float bf2f(unsigned short u) { return __uint_as_float((unsigned)u << 16); }

struct TrItem { const float* W; const float* kscale; bf16_t* WT; const float* bias_sh; float* bias_out; int N, k0, n0, ldt, drow0; bool rperm, nt; };
__device__ __forceinline__ void tr_load(f32x4 (&v)[16], const TrItem& t, int lane) {
    const int r4 = lane >> 4, c4 = lane & 15;
#pragma unroll
    for (int i = 0; i < 16; ++i) v[i] = __builtin_nontemporal_load((const f32x4*)(t.W + (size_t)(t.k0 + r4 + 4 * i) * t.N + t.n0 + 4 * c4));
}
__device__ __forceinline__ void tr_finish(const f32x4 (&v)[16], const TrItem& t, LAS float* scr, int lane) {
    const int r4 = lane >> 4, c4 = lane & 15;
#pragma unroll
    for (int i = 0; i < 16; ++i) { const int kk = r4 + 4 * i; f32x4 w = v[i]; if (t.kscale) w = w * t.kscale[t.k0 + kk]; LAS float* d = scr + kk * 65 + 4 * c4; d[0] = w[0]; d[1] = w[1]; d[2] = w[2]; d[3] = w[3]; }
    LDS_WAIT();
    if (t.bias_out) {
        float a0 = 0.f, a1 = 0.f, a2 = 0.f, a3 = 0.f; const float* sh = t.bias_sh + t.k0;
#pragma unroll 1
        for (int k4 = 0; k4 < 64; k4 += 4) { const f32x4 s0 = *(const f32x4*)(sh + k4), s1 = *(const f32x4*)(sh + 12288 + k4), s2 = *(const f32x4*)(sh + 2 * 12288 + k4), s3 = *(const f32x4*)(sh + 3 * 12288 + k4);
#pragma unroll
            for (int e = 0; e < 4; ++e) { const float w = scr[(k4 + e) * 65 + lane]; a0 += w * s0[e]; a1 += w * s1[e]; a2 += w * s2[e]; a3 += w * s3[e]; } }
        atomicAdd(t.bias_out + lane, a0); atomicAdd(t.bias_out + 11264 + lane, a1); atomicAdd(t.bias_out + 2 * 11264 + lane, a2); atomicAdd(t.bias_out + 3 * 11264 + lane, a3);
    }
    const int c = lane & 7;
#pragma unroll
    for (int j = 0; j < 8; ++j) { const int n = (lane >> 3) + 8 * j; const int sn = t.rperm ? ((n & 32) | (((n >> 2) & 1) * 16 + ((n >> 3) & 3) * 4 + (n & 3))) : n;
        const LAS float* s = scr + (8 * c) * 65 + sn;
        u32x4 o; o.x = cvtpk(s[0], s[65]); o.y = cvtpk(s[130], s[195]); o.z = cvtpk(s[260], s[325]); o.w = cvtpk(s[390], s[455]);
        u32x4* dp = (u32x4*)(t.WT + (size_t)(t.drow0 + n) * t.ldt + t.k0 + 8 * c); if (t.nt) __builtin_nontemporal_store(o, dp); else *dp = o; }
    LDS_WAIT();
}
#define TR_LOOP(DECODE, FIRST, COUNT, STRIDE) do { int it_ = (FIRST); f32x4 va_[16], vb_[16]; TrItem ta_, tb_; \
    if (it_ < (COUNT)) { ta_ = DECODE(it_); tr_load(va_, ta_, lane); } \
    while (it_ < (COUNT)) { int nx_ = it_ + (STRIDE); if (nx_ < (COUNT)) { tb_ = DECODE(nx_); tr_load(vb_, tb_, lane); } tr_finish(va_, ta_, scr, lane); it_ = nx_; if (it_ >= (COUNT)) break; \
        nx_ = it_ + (STRIDE); if (nx_ < (COUNT)) { ta_ = DECODE(nx_); tr_load(va_, ta_, lane); } tr_finish(vb_, tb_, scr, lane); it_ = nx_; } } while (0)
struct Cx { float re, im; };
__device__ __forceinline__ Cx cmul(Cx a, Cx b) { Cx r; r.re = a.re * b.re - a.im * b.im; r.im = a.re * b.im + a.im * b.re; return r; }
__device__ __forceinline__ Cx cpowk(float lr, float li, float dt, float k) {
    const float mag = __builtin_amdgcn_exp2f(k * lr * dt * 1.4426950408889634f);
    float rev = k * (li * dt * 0.15915494309189535f); rev -= floorf(rev);
    Cx r; r.re = mag * __builtin_amdgcn_cosf(rev); r.im = mag * __builtin_amdgcn_sinf(rev); return r; }
__device__ __forceinline__ Cx s5_coef(float lr, float li, float dt) {
    const Cx ab = cpowk(lr, li, dt, 1.f); const float den = lr * lr + li * li, nr = ab.re - 1.f, ni = ab.im;
    Cx r; r.re = (nr * lr + ni * li) / den; r.im = (ni * lr - nr * li) / den; return r; }

#define XB_TMO      128
#define XB_XCNT(j)  (256  + 64 * (j))
#define XB_XSUB(j)  (1280 + 64 * (j))
#define XB_XGEN(j)  (2304 + 64 * (j))
#define XB_TOP      3328
#define XB_TOPGEN   3392
#define XCD_BAR_WORDS 3456
#define XB_SPIN_CAP (1u << 18)

__device__ __forceinline__ unsigned xb_ld(unsigned* p)              { return __hip_atomic_load(p, __ATOMIC_RELAXED, __HIP_MEMORY_SCOPE_AGENT); }
__device__ __forceinline__ unsigned xb_add(unsigned* p, unsigned v) { return __hip_atomic_fetch_add(p, v, __ATOMIC_RELAXED, __HIP_MEMORY_SCOPE_AGENT); }
__device__ __forceinline__ unsigned xb_xcc_id() { return (unsigned)__builtin_amdgcn_s_getreg((3 << 11) | 20) & 0xFu; }
#define XB_SPIN(cond, bar) do { unsigned _sp = 0; while (cond) { __builtin_amdgcn_s_sleep(1); \
    if ((++_sp & 255u) == 0u) { if (xb_ld(&(bar)[XB_TMO])) break; if (_sp > XB_SPIN_CAP) { atomicAdd(&(bar)[XB_TMO], 1u); break; } } } } while (0)

struct XcdBarrier {
    unsigned* bar; unsigned x;
    volatile LAS unsigned* st;
};

__device__ __forceinline__ XcdBarrier xcd_barrier_post(unsigned* bar, volatile LAS unsigned* st) {
    XcdBarrier b; b.bar = bar; b.x = xb_xcc_id(); b.st = st;
    if (threadIdx.x == 0) (void)xb_add(&bar[XB_XCNT(b.x)], 1u);
    return b;
}
__device__ __forceinline__ void xcd_barrier_complete(unsigned* bar, unsigned x, unsigned& nloc, unsigned& nx) {
    const unsigned G = gridDim.x * gridDim.y * gridDim.z;
    unsigned sum, cnt, mine, sp = 0u;
    for (;;) {
        sum = 0u; cnt = 0u; mine = 0u;
#pragma unroll
        for (unsigned j = 0; j < 16; ++j) { const unsigned c = xb_ld(&bar[XB_XCNT(j)]); sum += c; cnt += (c > 0u) ? 1u : 0u; mine = (j == x) ? c : mine; }
        if (sum == G) break;
        __builtin_amdgcn_s_sleep(1);
        if ((++sp & 255u) == 0u) { if (xb_ld(&bar[XB_TMO])) break; if (sp > XB_SPIN_CAP) { atomicAdd(&bar[XB_TMO], 1u); break; } }
    }
    nloc = mine > 0u ? mine : 1u; nx = cnt > 0u ? cnt : 1u;
}

__device__ __forceinline__ void xcd_barrier(const XcdBarrier& b) {
    asm volatile("s_waitcnt vmcnt(0)" ::: "memory");
    __syncthreads();
    if (threadIdx.x == 0) {
        unsigned* bar = b.bar;
        __builtin_amdgcn_s_waitcnt(0);
        unsigned nloc = b.st[0], nx = b.st[1];
        if (nloc == 0u) { xcd_barrier_complete(bar, b.x, nloc, nx); b.st[0] = nloc; b.st[1] = nx; }
        const unsigned old = xb_add(&bar[XB_XSUB(b.x)], 1u);
        const unsigned gen = old / nloc;
        if (old + 1u == (gen + 1u) * nloc) {
            __builtin_amdgcn_fence(__ATOMIC_RELEASE, "agent");
            asm volatile("s_waitcnt vmcnt(0)" ::: "memory");
            const unsigned og = xb_add(&bar[XB_TOP], 1u);
            const unsigned tg = og / nx;
            if (og + 1u == (tg + 1u) * nx) xb_add(&bar[XB_TOPGEN], 1u);
            else XB_SPIN(xb_ld(&bar[XB_TOPGEN]) == tg, bar);
            __builtin_amdgcn_fence(__ATOMIC_ACQUIRE, "agent");
            xb_add(&bar[XB_XGEN(b.x)], 1u);
            asm volatile("s_waitcnt vmcnt(0)" ::: "memory");
        } else {
            XB_SPIN(xb_ld(&bar[XB_XGEN(b.x)]) == gen, bar);
            __builtin_amdgcn_fence(__ATOMIC_ACQUIRE, "agent");
            asm volatile("s_waitcnt vmcnt(0)" ::: "memory");
        }
    }
    __syncthreads();
}


namespace att {
constexpr float SCALE = 0.07216878364870323f;
constexpr float THR = 8.f;
#define KSWZ(row, colB) ((row) * 256 + ((colB) ^ (((row) & 7) << 4)))
#define RSWZ(row, colB) ((row) * 128 + ((colB) ^ ((((row) >> 1) & 7) << 4)))
#define SBAR() __builtin_amdgcn_sched_barrier(0)
__device__ __forceinline__ int crow(int r, int hi) { return (r & 3) + 8 * (r >> 2) + 4 * hi; }
__device__ __forceinline__ void partialSM(f32x16& p0, f32x16& p1, float& m_reg, float& mn, float& alpha) {
  constexpr float C = SCALE * 1.4426950408889634f;
  float pmax = p0[0];
#pragma unroll
  for (int r = 1; r < 16; ++r) pmax = fmaxf(pmax, p0[r]);
#pragma unroll
  for (int r = 0; r < 16; ++r) pmax = fmaxf(pmax, p1[r]);
  { auto rr = __builtin_amdgcn_permlane32_swap(__float_as_uint(pmax), __float_as_uint(pmax), false, false);
    pmax = fmaxf(__uint_as_float(rr[0]), __uint_as_float(rr[1])); }
  if (__builtin_expect(__all(pmax - m_reg <= THR / SCALE), 1)) { mn = m_reg; alpha = 1.f; }
  else { mn = fmaxf(m_reg, pmax); alpha = __builtin_amdgcn_exp2f((m_reg - mn) * C); m_reg = mn; }
  const float mnC = -mn * C;
#pragma unroll
  for (int r = 0; r < 16; ++r) p0[r] = fmaf(p0[r], C, mnC);
#pragma unroll
  for (int r = 0; r < 16; ++r) p1[r] = fmaf(p1[r], C, mnC);
#pragma unroll
  for (int r = 0; r < 16; ++r) p0[r] = __builtin_amdgcn_exp2f(p0[r]);
}
__device__ __forceinline__ void finishSM(f32x16& p0, f32x16& p1, float alpha, float& l_reg, bf16x8& pa0, bf16x8& pa1, bf16x8& pa2, bf16x8& pa3) {
#pragma unroll
  for (int r = 0; r < 16; ++r) p1[r] = __builtin_amdgcn_exp2f(p1[r]);
  float ps = 0;
#pragma unroll
  for (int r = 0; r < 16; ++r) ps += p0[r];
#pragma unroll
  for (int r = 0; r < 16; ++r) ps += p1[r];
  { auto rr = __builtin_amdgcn_permlane32_swap(__float_as_uint(ps), __float_as_uint(ps), false, false);
    ps = __uint_as_float(rr[0]) + __uint_as_float(rr[1]); }
  l_reg = l_reg * alpha + ps;
#define PK4(P, BASE, OUT) do { unsigned a0 = cvtpk(P[BASE + 0], P[BASE + 1]), a1 = cvtpk(P[BASE + 2], P[BASE + 3]);   \
    unsigned b0 = cvtpk(P[BASE + 4], P[BASE + 5]), b1 = cvtpk(P[BASE + 6], P[BASE + 7]);                              \
    auto r0 = __builtin_amdgcn_permlane32_swap(a0, b0, false, false); auto r1 = __builtin_amdgcn_permlane32_swap(a1, b1, false, false); \
    u32x4 w = {r0[0], r1[0], r0[1], r1[1]}; OUT = __builtin_bit_cast(bf16x8, w); } while (0)
  PK4(p0, 0, pa0); PK4(p0, 8, pa1); PK4(p1, 0, pa2); PK4(p1, 8, pa3);
#undef PK4
}
__device__ __forceinline__ void qkt(f32x16& p0, f32x16& p1, const char* Ks, const char* Rs, const bf16x8* qr, int r32, int hi) {
  p0 = f32x16{}; p1 = f32x16{};
#pragma unroll
  for (int d0 = 0; d0 < 8; ++d0) { const int cb = (d0 * 16 + hi * 8) * 2;
    const bf16x8 b0 = *reinterpret_cast<const bf16x8*>(Ks + KSWZ(r32, cb));
    const bf16x8 b1 = *reinterpret_cast<const bf16x8*>(Ks + KSWZ(32 + r32, cb));
    p0 = __builtin_amdgcn_mfma_f32_32x32x16_bf16(b0, qr[d0], p0, 0, 0, 0);
    p1 = __builtin_amdgcn_mfma_f32_32x32x16_bf16(b1, qr[d0], p1, 0, 0, 0); }
#pragma unroll
  for (int d0 = 0; d0 < 4; ++d0) { const int cb = (d0 * 16 + hi * 8) * 2;
    const bf16x8 b0 = *reinterpret_cast<const bf16x8*>(Rs + RSWZ(r32, cb));
    const bf16x8 b1 = *reinterpret_cast<const bf16x8*>(Rs + RSWZ(32 + r32, cb));
    p0 = __builtin_amdgcn_mfma_f32_32x32x16_bf16(b0, qr[8 + d0], p0, 0, 0, 0);
    p1 = __builtin_amdgcn_mfma_f32_32x32x16_bf16(b1, qr[8 + d0], p1, 0, 0, 0); }
}
__device__ __forceinline__ int v_st(int k, int c) { const int kk = (k & ~0xC) | ((k & 4) << 1) | ((k & 8) >> 1); return ((kk >> 3) * 4 + (c >> 5)) * 512 + ((kk & 7) * 32 + (c & 31)) * 2; }
__device__ __forceinline__ int v_rd_base(int lane) { return ((lane & 3) << 3) | (((lane >> 2) & 3) << 6) | (((lane >> 4) & 1) << 5) | (((lane >> 5) & 1) << 8); }
constexpr int v_rd_off(int d0, int ks, int half) { return d0 * 512 + ks * 4096 + half * 2048; }
template <int OFF> __device__ __forceinline__ s16x4 tr_read(int vb) {
  s16x4 r; asm volatile("ds_read_b64_tr_b16 %0, %1 offset:%2" : "=&v"(r) : "v"(vb), "i"(OFF) : "memory"); return r;
}
template <int D0> __device__ __forceinline__ void pv_one(f32x16& od, int vb, bf16x8 pa0, bf16x8 pa1, bf16x8 pa2, bf16x8 pa3) {
  const s16x4 l0 = tr_read<v_rd_off(D0, 0, 0)>(vb), h0 = tr_read<v_rd_off(D0, 0, 1)>(vb), l1 = tr_read<v_rd_off(D0, 1, 0)>(vb), h1 = tr_read<v_rd_off(D0, 1, 1)>(vb);
  const s16x4 l2 = tr_read<v_rd_off(D0, 2, 0)>(vb), h2 = tr_read<v_rd_off(D0, 2, 1)>(vb), l3 = tr_read<v_rd_off(D0, 3, 0)>(vb), h3 = tr_read<v_rd_off(D0, 3, 1)>(vb);
  asm volatile("s_waitcnt lgkmcnt(0)" ::: "memory"); SBAR();
#define PK(L, H) (bf16x8){L[0], L[1], L[2], L[3], H[0], H[1], H[2], H[3]}
  od = __builtin_amdgcn_mfma_f32_32x32x16_bf16(pa0, PK(l0, h0), od, 0, 0, 0);
  od = __builtin_amdgcn_mfma_f32_32x32x16_bf16(pa1, PK(l1, h1), od, 0, 0, 0);
  od = __builtin_amdgcn_mfma_f32_32x32x16_bf16(pa2, PK(l2, h2), od, 0, 0, 0);
  od = __builtin_amdgcn_mfma_f32_32x32x16_bf16(pa3, PK(l3, h3), od, 0, 0, 0);
#undef PK
}
__device__ __forceinline__ void pv_d0(f32x16* o, int vb, bf16x8 pa0, bf16x8 pa1, bf16x8 pa2, bf16x8 pa3) {
  pv_one<0>(o[0], vb, pa0, pa1, pa2, pa3); pv_one<1>(o[1], vb, pa0, pa1, pa2, pa3); pv_one<2>(o[2], vb, pa0, pa1, pa2, pa3); pv_one<3>(o[3], vb, pa0, pa1, pa2, pa3);
}
#define GLDS16(gp, lp) __builtin_amdgcn_global_load_lds((const unsigned*)(gp), (LAS unsigned*)(lp), 16, 0, 0)
__device__ __forceinline__ void attn_unit(int b, int h, int qb, const bf16_t* __restrict__ Q, const bf16_t* __restrict__ KN, const bf16_t* __restrict__ KR, const bf16_t* __restrict__ V, bf16_t* __restrict__ O, char* lds, LAS unsigned char* L3) {
  const int tid = opaque_tid(), wid = __builtin_amdgcn_readfirstlane(tid >> 6), lane = tid & 63, r32 = lane & 31, hi = lane >> 5;
  char* K_lds = lds + 49152; char* R_lds = lds + 81920;
  float* ws = (float*)(lds + 98304) + wid * 64; float* li_l = ws; float* al_l = ws + 32;
  float m_reg = -1e30f, l_reg = 0; f32x16 o[4] = {}; bf16x8 qr[12];
  const size_t qrow0 = (size_t)b * 2048 + qb * 256 + wid * 32;
  const bf16_t* Qw = Q + (qrow0 + r32) * 1536 + h * 192 + hi * 8;
#pragma unroll
  for (int d0 = 0; d0 < 12; ++d0) qr[d0] = __builtin_nontemporal_load(reinterpret_cast<const bf16x8*>(Qw + d0 * 16));
  const int vb0 = (int)(uintptr_t)lds + v_rd_base(lane);
  int ko[2], vo[2], ro;
#pragma unroll
  for (int e = 0; e < 2; ++e) { const int q = wid * 2 + e; const int krow = 4 * q + (lane >> 4); ko[e] = krow * 1024 + h * 128 + (((lane & 15) ^ (krow & 7)) * 8);
    const int st = 2 * q + (lane >> 5), kk = (st >> 2) * 8 + ((lane >> 2) & 7), k = (kk & ~0xC) | ((kk & 4) << 1) | ((kk & 8) >> 1); vo[e] = k * 1024 + h * 128 + (st & 3) * 32 + (lane & 3) * 8; }
  { const int rrow = 8 * wid + (lane >> 3); ro = rrow * 64 + (((lane & 7) ^ ((rrow >> 1) & 7)) * 8); }
#define TROW(t) ((size_t)((t) < 32 ? b * 2048 + (t) * 64 : 8192 + b * 256 + ((t) - 32) * 64))
#define DMA(t, vbuf) do { const size_t r0_ = TROW(t); const bf16_t* kb_ = KN + r0_ * 1024; const bf16_t* vb_ = V + r0_ * 1024; const bf16_t* rb_ = KR + r0_ * 64; const int kb2_ = ((t) & 1); \
    GLDS16(kb_ + ko[0], L3 + 49152 + kb2_ * 16384 + (wid * 2) * 1024); GLDS16(kb_ + ko[1], L3 + 49152 + kb2_ * 16384 + (wid * 2 + 1) * 1024); \
    GLDS16(vb_ + vo[0], L3 + (vbuf) + (wid * 2) * 1024); GLDS16(vb_ + vo[1], L3 + (vbuf) + (wid * 2 + 1) * 1024); \
    GLDS16(rb_ + ro, L3 + 81920 + kb2_ * 8192 + wid * 1024); } while (0)
#define RESC(a) do { if (__any((a) < 1.f)) { if (hi == 0) al_l[r32] = (a); asm volatile("s_waitcnt lgkmcnt(0)" ::: "memory"); \
    _Pragma("unroll") for (int d = 0; d < 4; ++d) _Pragma("unroll") for (int r = 0; r < 16; ++r) o[d][r] *= al_l[crow(r, hi)]; } } while (0)
#define TOPBAR() do { asm volatile("s_waitcnt vmcnt(0)" ::: "memory"); __syncthreads(); } while (0)
#define VNEXT(x) ((x) == 32768 ? 0 : (x) + 16384)
  f32x16 pA0, pA1, pB0, pB1; float mnA, mnB, alA, alB; bf16x8 pa0, pa1, pa2, pa3; constexpr int NT = 36;
  int v_prev = 0, v_cur = 16384, v_nxt = 32768;
  DMA(0, 0); TOPBAR();
  DMA(1, 16384);
  qkt(pA0, pA1, K_lds, R_lds, qr, r32, hi); partialSM(pA0, pA1, m_reg, mnA, alA);
  for (int j = 1; j + 1 < NT; j += 2) {
    TOPBAR(); DMA(j + 1, v_nxt);
    SBAR(); qkt(pB0, pB1, K_lds + 16384, R_lds + 8192, qr, r32, hi);
    finishSM(pA0, pA1, alA, l_reg, pa0, pa1, pa2, pa3); SBAR();
    pv_d0(o, vb0 + v_prev, pa0, pa1, pa2, pa3); partialSM(pB0, pB1, m_reg, mnB, alB);
    RESC(alB);
    v_prev = v_cur; v_cur = v_nxt; v_nxt = VNEXT(v_nxt);
    TOPBAR(); if (j + 2 < NT) DMA(j + 2, v_nxt);
    SBAR(); qkt(pA0, pA1, K_lds, R_lds, qr, r32, hi);
    finishSM(pB0, pB1, alB, l_reg, pa0, pa1, pa2, pa3); SBAR();
    pv_d0(o, vb0 + v_prev, pa0, pa1, pa2, pa3); partialSM(pA0, pA1, m_reg, mnA, alA);
    RESC(alA);
    v_prev = v_cur; v_cur = v_nxt; v_nxt = VNEXT(v_nxt);
  }
  TOPBAR();
  SBAR(); qkt(pB0, pB1, K_lds + 16384, R_lds + 8192, qr, r32, hi);
  finishSM(pA0, pA1, alA, l_reg, pa0, pa1, pa2, pa3); SBAR();
  pv_d0(o, vb0 + v_prev, pa0, pa1, pa2, pa3); partialSM(pB0, pB1, m_reg, mnB, alB);
  RESC(alB);
  finishSM(pB0, pB1, alB, l_reg, pa0, pa1, pa2, pa3); SBAR();
  pv_d0(o, vb0 + v_cur, pa0, pa1, pa2, pa3);
  if (hi == 0) li_l[r32] = l_reg; asm volatile("s_waitcnt lgkmcnt(0)" ::: "memory");
  bf16_t* Ow = O + qrow0 * 1024 + h * 128 + r32;
#pragma unroll
  for (int r = 0; r < 16; ++r) { const int orow = crow(r, hi); const float rl = __builtin_amdgcn_rcpf(li_l[orow]);
#pragma unroll
    for (int d0 = 0; d0 < 4; ++d0) Ow[(size_t)orow * 1024 + d0 * 32] = (bf16_t)(cvtpk(o[d0][r] * rl, 0.f) & 0xffffu); }
  __syncthreads();
#undef TROW
#undef DMA
#undef RESC
#undef TOPBAR
#undef VNEXT
}
#undef SBAR
}

constexpr int S5_UL = 0, S5_UST = 1040, S5_HL = 75776, S5_HST = 528;
__device__ __forceinline__ float gelu_t(float x) { return x * sigm(1.5957691216057308f * x * (1.f + 0.044715f * x * x)); }
__device__ __forceinline__ void s5_unit(int g, int b, const bf16_t* __restrict__ Ub, const bf16_t* __restrict__ Kcomb, const bf16_t* __restrict__ Wtab, const bf16_t* __restrict__ Vtab,
                                        const float* a_re, const float* a_im, const float* log_dt, bf16_t* __restrict__ Z, LAS unsigned char* lds) {
    const int tid = opaque_tid(), lane = tid & 63, wave = __builtin_amdgcn_readfirstlane(tid >> 6), i = lane & 31, hi = lane >> 5;
    for (int idx = tid; idx < 4608; idx += 512) { const int tau = idx >> 1, half = idx & 1; const size_t row = tau < 256 ? (size_t)8192 + b * 256 + tau : (size_t)b * 2048 + tau - 256;
        *(LAS u32x4*)(lds + S5_UL + (tau >> 5) * S5_UST + (tau & 31) * 32 + half * 16) = *(const u32x4*)(Ub + row * 1024 + g * 16 + half * 8); }
    __syncthreads();
    {
        f32x16 a0 = {}, a1 = {}, a2 = {};
        const bf16_t* wt = Wtab + (size_t)g * 32 * 4096 + (wave * 32 + i) * 16 + hi * 8;
        const int c2 = (64 + i) < 72 ? 64 + i : 71;
        const LAS unsigned char* u0 = lds + S5_UL + i * S5_UST + hi * 16; const LAS unsigned char* u1 = lds + S5_UL + (32 + i) * S5_UST + hi * 16; const LAS unsigned char* u2 = lds + S5_UL + c2 * S5_UST + hi * 16;
#pragma unroll 16
        for (int s = 0; s < 32; ++s) { const bf16x8 af = *(const bf16x8*)(wt + s * 4096);
            a0 = __builtin_amdgcn_mfma_f32_32x32x16_bf16(af, *(const LAS bf16x8*)(u0 + s * 32), a0, 0, 0, 0);
            a1 = __builtin_amdgcn_mfma_f32_32x32x16_bf16(af, *(const LAS bf16x8*)(u1 + s * 32), a1, 0, 0, 0);
            a2 = __builtin_amdgcn_mfma_f32_32x32x16_bf16(af, *(const LAS bf16x8*)(u2 + s * 32), a2, 0, 0, 0); }
#pragma unroll
        for (int rr = 0; rr < 4; ++rr) { const int np = wave * 32 + 8 * rr + 4 * hi; u32x2 w;
            w.x = cvtpk(a0[4 * rr], a0[4 * rr + 1]); w.y = cvtpk(a0[4 * rr + 2], a0[4 * rr + 3]); *(LAS u32x2*)(lds + S5_HL + i * S5_HST + np * 2) = w;
            w.x = cvtpk(a1[4 * rr], a1[4 * rr + 1]); w.y = cvtpk(a1[4 * rr + 2], a1[4 * rr + 3]); *(LAS u32x2*)(lds + S5_HL + (32 + i) * S5_HST + np * 2) = w;
            w.x = cvtpk(a2[4 * rr], a2[4 * rr + 1]); w.y = cvtpk(a2[4 * rr + 2], a2[4 * rr + 3]); if (64 + i < 72) *(LAS u32x2*)(lds + S5_HL + (64 + i) * S5_HST + np * 2) = w; }
    }
    __syncthreads();
    if (wave < 2) { const int d = wave, n = lane, base = (d * 64 + g) * 64 + n; const Cx A32 = cpowk(a_re[base], a_im[base], __expf(log_dt[d * 64 + g]), 32.f);
        float hr = 0.f, him = 0.f; LAS unsigned char* hb = lds + S5_HL + (d * 128 + n) * 2;
#pragma unroll 4
        for (int st = 0; st < 72; ++st) { const int col = d == 0 ? st : (st < 8 ? 7 - st : 79 - st);
            LAS unsigned short* pr = (LAS unsigned short*)(hb + col * S5_HST); LAS unsigned short* pi = pr + 64;
            const float sre = bf2f(*pr), sim = bf2f(*pi);
            *pr = (unsigned short)(cvtpk(hr, 0.f) & 0xffffu); *pi = (unsigned short)(cvtpk(him, 0.f) & 0xffffu);
            const float nr = A32.re * hr - A32.im * him + sre, ni = A32.re * him + A32.im * hr + sim; hr = nr; him = ni; }
    }
    __syncthreads();
    f32x16 y00 = {}, y01 = {}, y10 = {}, y11 = {};
    {
        const int rb0 = 2 * wave;
        const bf16_t* kc = Kcomb + (size_t)g * 64 * 256 + (i >> 4) * 256 + (i & 15) * 16 + hi * 8;
        const LAS unsigned char* u0 = lds + S5_UL + (8 + i) * S5_UST + hi * 16; const LAS unsigned char* u1 = lds + S5_UL + (40 + i) * S5_UST + hi * 16;
#pragma unroll 16
        for (int s = 0; s < 32; ++s) { const bf16x8 f0 = *(const bf16x8*)(kc + (2 * rb0 - s + 32) * 256), f1 = *(const bf16x8*)(kc + (2 * rb0 + 2 - s + 32) * 256);
            const bf16x8 b0 = *(const LAS bf16x8*)(u0 + s * 32), b1 = *(const LAS bf16x8*)(u1 + s * 32);
            y00 = __builtin_amdgcn_mfma_f32_32x32x16_bf16(f0, b0, y00, 0, 0, 0); y01 = __builtin_amdgcn_mfma_f32_32x32x16_bf16(f0, b1, y01, 0, 0, 0);
            y10 = __builtin_amdgcn_mfma_f32_32x32x16_bf16(f1, b0, y10, 0, 0, 0); y11 = __builtin_amdgcn_mfma_f32_32x32x16_bf16(f1, b1, y11, 0, 0, 0); }
        const bf16_t* vt = Vtab + ((size_t)g * 16 + rb0) * 16 * 512 + i * 16 + hi * 8;
        const LAS unsigned char* h0 = lds + S5_HL + (8 + i) * S5_HST + hi * 16; const LAS unsigned char* h1 = lds + S5_HL + (40 + i) * S5_HST + hi * 16;
#pragma unroll 16
        for (int kk = 0; kk < 16; ++kk) { const bf16x8 f0 = *(const bf16x8*)(vt + kk * 512), f1 = *(const bf16x8*)(vt + 16 * 512 + kk * 512);
            const bf16x8 b0 = *(const LAS bf16x8*)(h0 + kk * 32), b1 = *(const LAS bf16x8*)(h1 + kk * 32);
            y00 = __builtin_amdgcn_mfma_f32_32x32x16_bf16(f0, b0, y00, 0, 0, 0); y01 = __builtin_amdgcn_mfma_f32_32x32x16_bf16(f0, b1, y01, 0, 0, 0);
            y10 = __builtin_amdgcn_mfma_f32_32x32x16_bf16(f1, b0, y10, 0, 0, 0); y11 = __builtin_amdgcn_mfma_f32_32x32x16_bf16(f1, b1, y11, 0, 0, 0); }
    }
    __syncthreads();
    {
        LAS unsigned char* zs = lds + S5_UL + wave * 8192;
#define S5_ST(ACC, RBI, NB) _Pragma("unroll") for (int rr = 0; rr < 4; ++rr) { const int tl = (RBI) * 2 + (rr >> 1), p0 = 8 * (rr & 1) + 4 * hi, ch = 32 * (NB) + i; u32x2 w; \
            w.x = cvtpk(gelu_t(ACC[4 * rr]), gelu_t(ACC[4 * rr + 1])); w.y = cvtpk(gelu_t(ACC[4 * rr + 2]), gelu_t(ACC[4 * rr + 3])); *(LAS u32x2*)(zs + (tl * 64 + ch) * 32 + p0 * 2) = w; }
        S5_ST(y00, 0, 0) S5_ST(y01, 0, 1) S5_ST(y10, 1, 0) S5_ST(y11, 1, 1)
#undef S5_ST
        LDS_WAIT();
#pragma unroll
        for (int j = 0; j < 8; ++j) { const int tok = j * 32 + (lane >> 1), half = lane & 1, tl = tok >> 6, ch = tok & 63; const u32x4 v = *(const LAS u32x4*)(zs + tok * 32 + half * 16);
            *(u32x4*)(Z + ((size_t)b * 2048 + ch * 32 + 4 * wave + tl) * 1024 + g * 16 + half * 8) = v; }
    }
    __syncthreads();
}

__global__ void __launch_bounds__(512) fwd_kernel(Params P) {
    extern __shared__ __attribute__((aligned(16))) unsigned char lds[];
    cg::grid_group grid = cg::this_grid();
    LAS unsigned char* L = (LAS unsigned char*)lds;
    const int G = gridDim.x, bx = blockIdx.x, vcu = (G % 8 == 0) ? (bx % 8) * (G / 8) + bx / 8 : bx;
    const int NGW = G * 8;
    unsigned char* ws = P.ws;
    float* CTL = (float*)(ws + WS_CTL); float* MOD = (float*)(ws + WS_MOD); float* BIAS2 = (float*)(ws + WS_BIAS2);
    bf16_t *Wt_in = (bf16_t*)(ws + WS_WIN), *Wt_glu = (bf16_t*)(ws + WS_WGLU), *Wt_uq = (bf16_t*)(ws + WS_WUQ), *Wt_ukv = (bf16_t*)(ws + WS_WUKV), *Wt_mo = (bf16_t*)(ws + WS_WMO),
           *Wt_out = (bf16_t*)(ws + WS_WOUT), *Wt_f1 = (bf16_t*)(ws + WS_WF1), *Wt_f2 = (bf16_t*)(ws + WS_WF2);
    bf16_t *GATES = (bf16_t*)(ws + WS_GATES), *XMOD = (bf16_t*)(ws + WS_XMOD), *Ub = (bf16_t*)(ws + WS_U), *CQKV = (bf16_t*)(ws + WS_CQKV), *KR = (bf16_t*)(ws + WS_KR),
           *Kcomb = (bf16_t*)(ws + WS_KCOMB), *Wtab = (bf16_t*)(ws + WS_WTAB), *Vtab = (bf16_t*)(ws + WS_VTAB), *Qb = (bf16_t*)(ws + WS_Q), *KN = (bf16_t*)(ws + WS_KN), *Vb = (bf16_t*)(ws + WS_V),
           *Zb = (bf16_t*)(ws + WS_Z), *Ob = (bf16_t*)(ws + WS_O), *S5P = (bf16_t*)(ws + WS_S5P), *MIX = (bf16_t*)(ws + WS_MIX), *X1S = (bf16_t*)(ws + WS_X1S), *ACT = (bf16_t*)(ws + WS_ACT);
    float* X1 = (float*)(ws + WS_X1);
    const float *a_re = P.in[I_ARE], *a_im = P.in[I_AIM], *log_dt = P.in[I_LOGDT], *b_re = P.in[I_BRE], *b_im = P.in[I_BIM], *c_re = P.in[I_CRE], *c_im = P.in[I_CIM];

#ifndef PROBE_REP
#define PROBE_REP 0
#endif
    const bool split = (G == 256);
    { volatile LAS unsigned* st_ = (volatile LAS unsigned*)(L + 147392); if (threadIdx.x == 0) { st_[0] = 0u; st_[1] = 0u; } __syncthreads(); }
    const XcdBarrier xbar = xcd_barrier_post((unsigned*)(CTL + 131072), (volatile LAS unsigned*)(L + 147392));
    if (PROBE_REP & 1024) { for (int q_ = 0; q_ < 8; ++q_) xcd_barrier(xbar); }
    for (int rep_ = 0; rep_ < ((PROBE_REP & 1) ? 2 : 1); ++rep_) {
    {
        const int tid = opaque_tid(), lane = tid & 63, wave = __builtin_amdgcn_readfirstlane(tid >> 6);
        if (!split || bx < 192) {
        LAS float* scl = (LAS float*)L;
        LAS f32x4* red = (LAS f32x4*)(L + 40960);
        for (int i = tid; i < 5 * 2048; i += 512) { const int v = i >> 11, k = i & 2047; const float cv = v < 4 ? P.in[I_C][v * 2048 + k] : P.in[I_CCTX][k]; scl[i] = cv * sigm(cv); }
        __syncthreads();
        for (int rp2_ = 0; rp2_ < ((PROBE_REP & 128) ? 2 : 1); ++rp2_)
        for (int item = bx; item < 192; item += G) {
            const int n0 = item * 64, c4 = lane & 15, rsub = lane >> 4;
            f32x4 a[5];
#pragma unroll
            for (int v = 0; v < 5; ++v) a[v] = (f32x4){0.f, 0.f, 0.f, 0.f};
            const float* wp = P.in[I_WMOD] + (size_t)(wave * 4 + rsub) * 12288 + n0 + c4 * 4;
#pragma unroll 8
            for (int it = 0; it < 64; ++it) { const int k = wave * 4 + rsub + 32 * it; const f32x4 w = __builtin_nontemporal_load((const f32x4*)(wp + (size_t)it * 32 * 12288));
#pragma unroll
                for (int v = 0; v < 5; ++v) a[v] += w * scl[v * 2048 + k]; }
#pragma unroll
            for (int v = 0; v < 5; ++v)
#pragma unroll
                for (int e = 0; e < 4; ++e) { float t = a[v][e]; t += __shfl_xor(t, 16); t += __shfl_xor(t, 32); a[v][e] = t; }
            if (lane < 16) {
#pragma unroll
                for (int v = 0; v < 5; ++v) red[(wave * 16 + c4) * 5 + v] = a[v]; }
            __syncthreads();
            if (tid < 80) { const int cc = tid & 15, v = tid >> 4; f32x4 s = *(const f32x4*)(P.in[I_BMOD] + n0 + cc * 4);
#pragma unroll
                for (int w = 0; w < 8; ++w) s += red[(w * 16 + cc) * 5 + v];
                *(f32x4*)(MOD + (size_t)v * 12288 + n0 + cc * 4) = s; }
            __syncthreads();
        }
        }
        if (!split || bx >= 192) {
        __syncthreads();
        LAS float* scr = (LAS float*)(L + wave * 16640);
        const int w0 = (split ? bx - 192 : bx) * 8 + wave, nw = (split ? 64 : G) * 8;
        auto dec_in = [&](int it) { TrItem t; t.nt = false; t.bias_sh = nullptr; t.bias_out = nullptr; const int kb = it / 93, n0 = (it % 93) * 64; t.W = P.in[I_WIN]; t.kscale = nullptr; t.WT = Wt_in; t.N = 5952; t.k0 = kb * 64; t.n0 = n0; t.ldt = 2048; t.drow0 = n0 < 1856 ? n0 : n0 + 192; t.rperm = (n0 == 1792); return t; };
        for (int rp4_ = 0; rp4_ < ((PROBE_REP & 512) ? 2 : 1); ++rp4_)
        TR_LOOP(dec_in, w0, 32 * 93, nw);
        for (int i = w0 * 64 + lane; i < 192 * 2048 / 8; i += nw * 64) *(u32x4*)(Wt_in + (size_t)1856 * 2048 + (size_t)i * 8) = (u32x4){0u, 0u, 0u, 0u};
        }
    }
    if (split) xcd_barrier(xbar); else grid.sync();
    }
    for (int rep_ = 0; rep_ < ((PROBE_REP & 32) ? 2 : 1); ++rep_) {
    {
        const int tid = opaque_tid(), lane = tid & 63, wave = __builtin_amdgcn_readfirstlane(tid >> 6);
        if (wave >= 4) {
        const int w0 = bx * 4 + (wave - 4), nw = G * 4; LAS float* scr = (LAS float*)(L + (wave - 4) * 8704);
        for (int it = w0; it < 64 * 63; it += nw) { const int g = it / 63, e = it % 63 + 1, dd = e - 32, p = lane >> 2, q0 = (lane & 3) * 4; float acc[4] = {0.f, 0.f, 0.f, 0.f};
            for (int d = 0; d < 2; ++d) { if ((dd > 0 && d == 1) || (dd < 0 && d == 0)) continue;
                { const int n = lane, base = (d * 64 + g) * 64 + n; const float lr = a_re[base], li = a_im[base], dt = __expf(log_dt[d * 64 + g]); const Cx co = s5_coef(lr, li, dt), pw = cpowk(lr, li, dt, (float)(dd < 0 ? -dd : dd));
                    scr[2 * n] = pw.re; scr[2 * n + 1] = pw.im;
#pragma unroll
                    for (int q = 0; q < 16; q += 4) { const f32x4 brv = *(const f32x4*)(b_re + (size_t)base * 16 + q), biv = *(const f32x4*)(b_im + (size_t)base * 16 + q);
#pragma unroll
                        for (int j = 0; j < 4; ++j) { Cx bq; bq.re = brv[j]; bq.im = biv[j]; const Cx bb = cmul(co, bq); scr[128 + n * 16 + q + j] = bb.re; scr[1152 + n * 16 + q + j] = bb.im; } } }
                LDS_WAIT();
                const float* cr = c_re + ((size_t)(d * 64 + g) * 16 + p) * 64; const float* cim = c_im + ((size_t)(d * 64 + g) * 16 + p) * 64;
#pragma unroll 4
                for (int n4 = 0; n4 < 64; n4 += 4) { const f32x4 crv = *(const f32x4*)(cr + n4), civ = *(const f32x4*)(cim + n4);
#pragma unroll
                    for (int e2 = 0; e2 < 4; ++e2) { const int n2 = n4 + e2; Cx c; c.re = crv[e2]; c.im = civ[e2]; Cx pn; pn.re = scr[2 * n2]; pn.im = scr[2 * n2 + 1]; const Cx ca = cmul(c, pn);
                        const f32x4 bre = *(const LAS f32x4*)(scr + 128 + n2 * 16 + q0), bim = *(const LAS f32x4*)(scr + 1152 + n2 * 16 + q0);
#pragma unroll
                        for (int j = 0; j < 4; ++j) acc[j] += ca.re * bre[j] - ca.im * bim[j]; } }
                LDS_WAIT();
            }
            if (dd == 0) { const float dsk = P.in[I_D][g * 16 + p];
#pragma unroll
                for (int j = 0; j < 4; ++j) if (q0 + j == p) acc[j] += dsk; }
            u32x2 w; w.x = cvtpk(acc[0], acc[1]); w.y = cvtpk(acc[2], acc[3]); *(u32x2*)(Kcomb + ((size_t)(g * 64 + e) * 16 + p) * 16 + q0) = w; }
            } else {
        const int gw = bx * 4 + wave, NGW4 = G * 4;
        for (int row = gw; row < 9216; row += 2 * NGW4) { const int row2 = row + NGW4; const bool has2 = row2 < 9216; const int rB = has2 ? row2 : row;
            const float* srcA = row < 8192 ? P.in[I_X] + (size_t)row * 2048 : P.in[I_CTX] + (size_t)(row - 8192) * 2048; const int vA = row < 8192 ? row >> 11 : 4;
            const float* srcB = rB < 8192 ? P.in[I_X] + (size_t)rB * 2048 : P.in[I_CTX] + (size_t)(rB - 8192) * 2048; const int vB = rB < 8192 ? rB >> 11 : 4;
            f32x4 xa[8], xb[8]; float sa = 0.f, sb = 0.f;
#pragma unroll
            for (int j = 0; j < 8; ++j) xa[j] = __builtin_nontemporal_load((const f32x4*)srcA + 64 * j + lane);
#pragma unroll
            for (int j = 0; j < 8; ++j) xb[j] = __builtin_nontemporal_load((const f32x4*)srcB + 64 * j + lane);
#pragma unroll
            for (int j = 0; j < 8; ++j) { sa += dot4(xa[j]); sb += dot4(xb[j]); }
            const float rsA = __builtin_amdgcn_rsqf(wave_sum(sa) * (1.f / 2048.f) + 1e-6f), rsB = __builtin_amdgcn_rsqf(wave_sum(sb) * (1.f / 2048.f) + 1e-6f);
            const float* modA = MOD + (size_t)vA * 12288; const float* modB = MOD + (size_t)vB * 12288;
#pragma unroll
            for (int j = 0; j < 8; ++j) { const int c = (64 * j + lane) * 4; const f32x4 n1 = *(const f32x4*)(P.in[I_NORM1] + c);
                const f32x4 oa = xa[j] * rsA * n1 * (*(const f32x4*)(modA + 2048 + c) + 1.f) + *(const f32x4*)(modA + c);
                u32x2 w; w.x = cvtpk(oa[0], oa[1]); w.y = cvtpk(oa[2], oa[3]); *(u32x2*)(XMOD + (size_t)row * 2048 + c) = w;
                if (has2) { const f32x4 ob = xb[j] * rsB * n1 * (*(const f32x4*)(modB + 2048 + c) + 1.f) + *(const f32x4*)(modB + c);
                    u32x2 w2; w2.x = cvtpk(ob[0], ob[1]); w2.y = cvtpk(ob[2], ob[3]); *(u32x2*)(XMOD + (size_t)row2 * 2048 + c) = w2; } } }
        }
    }
    xcd_barrier(xbar);
    }
    for (int rq_ = 0; rq_ < ((PROBE_REP & 8) ? 2 : 1); ++rq_)
    { pg8::Gemm g{XMOD, Wt_in, 9216, 6144, 2048, 2048, 2048}; pg8::StaticOrder S; S.init(9216, 6144, G, bx);
      pg8::EpiIn E{Ub, CQKV, KR, GATES, CTL + SSQ_Q + rq_ * 65536, CTL + SSQ_KV + rq_ * 65536}; pg8::gemm_phase<pg8::EpiIn, pg8::StaticOrder, true, true>(L, g, S, E); }
    for (int rep_ = 0; rep_ < ((PROBE_REP & 64) ? 2 : 1); ++rep_)
    if (!split || bx >= 96) {
        const int tid = opaque_tid(), lane = tid & 63, wave = __builtin_amdgcn_readfirstlane(tid >> 6);
        const int w0 = (split ? bx - 96 : bx) * 8 + wave, nw = (split ? 160 : G) * 8;
        LAS float* scr = (LAS float*)(L + wave * 16640);
        constexpr int I_GLU = 16 * 64, I_UQ = 8 * 24, I_UKV = 4 * 32, I_MO = 16 * 32, I_OUT = 32 * 32, I_F1 = 32 * 176, I_F2 = 88 * 32;
        constexpr int NITEMS = I_GLU + I_UQ + I_UKV + I_MO + I_OUT + I_F1;
        auto dec_sh = [&](int it) { TrItem t; t.kscale = nullptr; t.rperm = false; t.nt = true; t.bias_sh = nullptr; t.bias_out = nullptr; int r = it;
            if (r < I_UQ) { const int kb = r / 24, n0 = (r % 24) * 64; t.W = P.in[I_WUQ]; t.kscale = P.in[I_QNORM]; t.WT = Wt_uq; t.N = 1536; t.k0 = kb * 64; t.n0 = n0; t.ldt = 512; t.drow0 = n0; t.rperm = (n0 % 192) == 128; return t; } r -= I_UQ;
            if (r < I_UKV) { const int kb = r / 32, n0 = (r % 32) * 64; t.W = P.in[I_WUKV]; t.kscale = P.in[I_KVNORM]; t.WT = Wt_ukv; t.N = 2048; t.k0 = kb * 64; t.n0 = n0; t.ldt = 256; t.drow0 = n0; return t; } r -= I_UKV;
            if (r < I_GLU) { const int kb = r / 64, n0 = (r % 64) * 64, j0 = n0 & 2047, hf = n0 >> 11; t.W = P.in[I_WGLU]; t.WT = Wt_glu; t.N = 4096; t.k0 = kb * 64; t.n0 = n0; t.ldt = 1024; t.drow0 = (j0 >> 7) * 256 + hf * 128 + (j0 & 127); return t; } r -= I_GLU;
            if (r < I_MO) { const int kb = r / 32, n0 = (r % 32) * 64; t.W = P.in[I_WMO]; t.WT = Wt_mo; t.N = 2048; t.k0 = kb * 64; t.n0 = n0; t.ldt = 1024; t.drow0 = n0; return t; } r -= I_MO;
            if (r < I_OUT) { const int kb = r / 32, n0 = (r % 32) * 64; t.W = P.in[I_WOUT]; t.WT = Wt_out; t.N = 2048; t.k0 = kb * 64; t.n0 = n0; t.ldt = 2048; t.drow0 = n0; return t; } r -= I_OUT;
            { const int kb = r / 176, n0 = (r % 176) * 64, j0 = n0 % 5632, hf = n0 / 5632; t.W = P.in[I_WF1]; t.WT = Wt_f1; t.N = 11264; t.k0 = kb * 64; t.n0 = n0; t.ldt = 2048; t.drow0 = (j0 >> 7) * 256 + hf * 128 + (j0 & 127); t.bias_sh = MOD + 3 * 2048; t.bias_out = BIAS2 + t.drow0; return t; } };
        TR_LOOP(dec_sh, w0, NITEMS, nw);
        for (int it = w0; it < 2048; it += nw) { const int g = it >> 5, s = it & 31, n = lane;
#pragma unroll
            for (int d = 0; d < 2; ++d) { const int base = (d * 64 + g) * 64 + n; const float lr = a_re[base], li = a_im[base], dt = __expf(log_dt[d * 64 + g]);
                const Cx pc = cmul(cpowk(lr, li, dt, d == 0 ? (float)(31 - s) : (float)s), s5_coef(lr, li, dt));
                const float* br = b_re + (size_t)base * 16; const float* bi = b_im + (size_t)base * 16; unsigned wre[8], wim[8];
#pragma unroll
                for (int q = 0; q < 16; q += 2) { Cx b0; b0.re = br[q]; b0.im = bi[q]; Cx b1; b1.re = br[q + 1]; b1.im = bi[q + 1]; const Cx v0 = cmul(pc, b0), v1 = cmul(pc, b1);
                    wre[q >> 1] = cvtpk(v0.re, v1.re); wim[q >> 1] = cvtpk(v0.im, v1.im); }
                bf16_t* dst = Wtab + ((size_t)(g * 32 + s) * 256 + d * 128 + n) * 16;
                *(u32x4*)dst = (u32x4){wre[0], wre[1], wre[2], wre[3]}; *(u32x4*)(dst + 8) = (u32x4){wre[4], wre[5], wre[6], wre[7]};
                *(u32x4*)(dst + 1024) = (u32x4){wim[0], wim[1], wim[2], wim[3]}; *(u32x4*)(dst + 1032) = (u32x4){wim[4], wim[5], wim[6], wim[7]}; } }
        for (int it = w0; it < 1024; it += nw) { const int g = it >> 4, kk = it & 15, i = lane & 31, hi = lane >> 5, th = i >> 4, p = i & 15, blk = kk >> 2, d = blk >> 1, isim = blk & 1, nb0 = (kk & 3) * 16 + 8 * hi;
            const float dt = __expf(log_dt[d * 64 + g]), e0 = d == 0 ? (float)(th + 1) : (float)(2 - th); const int base = (d * 64 + g) * 64 + nb0, ci = ((d * 64 + g) * 16 + p) * 64 + nb0;
            const f32x4 ar0 = *(const f32x4*)(a_re + base), ar1 = *(const f32x4*)(a_re + base + 4), ai0 = *(const f32x4*)(a_im + base), ai1 = *(const f32x4*)(a_im + base + 4);
            const f32x4 cr0 = *(const f32x4*)(c_re + ci), cr1 = *(const f32x4*)(c_re + ci + 4), ci0 = *(const f32x4*)(c_im + ci), ci1 = *(const f32x4*)(c_im + ci + 4);
            Cx pw[8], a2[8], cc[8];
#pragma unroll
            for (int j = 0; j < 8; ++j) { const float lr = j < 4 ? ar0[j & 3] : ar1[j & 3], li = j < 4 ? ai0[j & 3] : ai1[j & 3]; pw[j] = cpowk(lr, li, dt, e0); a2[j] = cpowk(lr, li, dt, 2.f); cc[j].re = j < 4 ? cr0[j & 3] : cr1[j & 3]; cc[j].im = j < 4 ? ci0[j & 3] : ci1[j & 3]; }
            for (int st = 0; st < 16; ++st) { const int rb = d == 0 ? st : 15 - st; float val[8];
#pragma unroll
                for (int j = 0; j < 8; ++j) { val[j] = isim ? -(cc[j].re * pw[j].im + cc[j].im * pw[j].re) : (cc[j].re * pw[j].re - cc[j].im * pw[j].im); pw[j] = cmul(pw[j], a2[j]); }
                *(u32x4*)(Vtab + ((((size_t)g * 16 + rb) * 16 + kk) * 32 + i) * 16 + 8 * hi) = (u32x4){cvtpk(val[0], val[1]), cvtpk(val[2], val[3]), cvtpk(val[4], val[5]), cvtpk(val[6], val[7])}; } }
    }
    xcd_barrier(xbar);
    for (int rep_ = 0; rep_ < ((PROBE_REP & 4) ? 2 : 1); ++rep_)
    for (int u = vcu; u < 256; u += G) s5_unit(u & 63, u >> 6, Ub, Kcomb, Wtab, Vtab, a_re, a_im, log_dt, Zb, L);
    for (int rq_ = 0; rq_ < ((PROBE_REP & 8192) ? 2 : 1); ++rq_)
    { pg8::Gemm g{CQKV, Wt_uq, 8192, 1536, 512, 768, 512}; pg8::StaticOrder S; S.init(8192, 1536, G, bx);
      pg8::EpiQ E{Qb, CTL + SSQ_Q}; pg8::gemm_phase<pg8::EpiQ, pg8::StaticOrder, true, true>(L, g, S, E); }
    __syncthreads();
    for (int rq_ = 0; rq_ < ((PROBE_REP & 8192) ? 2 : 1); ++rq_)
    { pg8::Gemm g{CQKV + 512, Wt_ukv, 9216, 2048, 256, 768, 256}; pg8::StaticOrder S; S.init(9216, 2048, G, (bx + 64) % G);
      pg8::EpiKV E{KN, Vb, CTL + SSQ_KV}; pg8::gemm_phase<pg8::EpiKV, pg8::StaticOrder, true, true>(L, g, S, E); }
    xcd_barrier(xbar);
    for (int rep_ = 0; rep_ < ((PROBE_REP & 2) ? 2 : 1); ++rep_)
    for (int u = vcu; u < 256; u += G) att::attn_unit(u >> 6, (u >> 3) & 7, u & 7, Qb, KN, KR, Vb, Ob, (char*)lds, L);
    for (int rq_ = 0; rq_ < ((PROBE_REP & 2048) ? 2 : 1); ++rq_)
    { pg8::Gemm g{Zb, Wt_glu, 8192, 4096, 1024, 1024, 1024}; pg8::StaticOrder S; S.init(8192, 4096, G, bx);
      pg8::EpiGlu E{S5P, GATES}; pg8::gemm_phase<pg8::EpiGlu, pg8::StaticOrder, true, true>(L, g, S, E); }
    xcd_barrier(xbar);
    for (int rq_ = 0; rq_ < ((PROBE_REP & 4096) ? 2 : 1); ++rq_)
    { pg8::Gemm g{Ob, Wt_mo, 8192, 2048, 1024, 1024, 1024}; pg8::StaticOrder S; S.init(8192, 2048, G, bx);
      pg8::EpiMix E{S5P, GATES, MIX}; pg8::gemm_phase<pg8::EpiMix, pg8::StaticOrder, true, true>(L, g, S, E); }
    xcd_barrier(xbar);
    for (int rq_ = 0; rq_ < ((PROBE_REP & 16384) ? 2 : 1); ++rq_)
    { pg8::Gemm g{MIX, Wt_out, 8192, 2048, 2048, 2048, 2048}; pg8::StaticOrder S; S.init(8192, 2048, G, bx);
      pg8::EpiOut E{P.in[I_X], MOD, P.in[I_NORM2], X1, CTL + SSQ_1 + rq_ * 65536, X1S}; pg8::gemm_phase<pg8::EpiOut, pg8::StaticOrder, true, true>(L, g, S, E); }
    xcd_barrier(xbar);
    for (int rep_ = 0; rep_ < ((PROBE_REP & 16) ? 2 : 1); ++rep_)
    { pg8::Gemm g{X1S, Wt_f1, 8192, 11264, 2048, 2048, 2048}; pg8::StaticOrder S; S.init(8192, 11264, G, bx);
      pg8::EpiFfn1 E{CTL + SSQ_1, BIAS2, ACT}; pg8::gemm_phase<pg8::EpiFfn1, pg8::StaticOrder, true, true>(L, g, S, E); }
    if (!split || bx >= 128) {
        const int tid = opaque_tid(), lane = tid & 63, wave = __builtin_amdgcn_readfirstlane(tid >> 6);
        const int w0 = (split ? bx - 128 : bx) * 8 + wave, nw = (split ? 128 : G) * 8;
        LAS float* scr = (LAS float*)(L + wave * 16640);
        auto dec_f2 = [&](int it) { TrItem t; t.kscale = nullptr; t.rperm = false; t.nt = false; t.bias_sh = nullptr; t.bias_out = nullptr; const int kb = it / 32, n0 = (it % 32) * 64; t.W = P.in[I_WF2]; t.WT = Wt_f2; t.N = 2048; t.k0 = kb * 64; t.n0 = n0; t.ldt = 5632; t.drow0 = n0; return t; };
        TR_LOOP(dec_f2, w0, 88 * 32, nw);
    }
    xcd_barrier(xbar);
    for (int rq_ = 0; rq_ < ((PROBE_REP & 32768) ? 2 : 1); ++rq_)
    { pg8::Gemm g{ACT, Wt_f2, 8192, 2048, 5632, 5632, 5632}; pg8::StaticOrder S; S.init(8192, 2048, G, bx);
      pg8::EpiFfn2 E{X1, MOD, P.in[I_NORMF], P.out, CTL + SSQ_2 + rq_ * 65536, (unsigned*)(CTL + 140000) + rq_ * 4096, split ? 1 : 0}; pg8::gemm_phase<pg8::EpiFfn2, pg8::StaticOrder, true, true>(L, g, S, E); }
    if (!split) {
    xcd_barrier(xbar);
    { const int tid = opaque_tid(), lane = tid & 63, wave = __builtin_amdgcn_readfirstlane(tid >> 6), gw = bx * 8 + wave;
    for (int row = gw; row < 8192; row += NGW) { const float rstd = __builtin_amdgcn_rsqf(CTL[SSQ_2 + row] * (1.f / 2048.f) + 1e-6f); f32x4* o = (f32x4*)(P.out + (size_t)row * 2048);
#pragma unroll
        for (int j = 0; j < 8; ++j) { const int c4 = 64 * j + lane; o[c4] = o[c4] * rstd * *(const f32x4*)(P.in[I_NORMF] + c4 * 4); } } }
    }
}

extern "C" void kernel_launch(void* const* d_in, const int* in_sizes, int n_in, void* d_out, int out_size, void* d_ws, size_t ws_size, hipStream_t stream) {
    static int grid = 0;
    if (grid == 0) {
        if (n_in != 27 || out_size != 8192 * 2048 || ws_size < WS_END) { fprintf(stderr, "kernel_launch: unexpected shapes (n_in %d out %d ws %zu)\n", n_in, out_size, ws_size); grid = -1; return; }
        int dev = 0, cus = 0, per_cu = 0;
        if (hipGetDevice(&dev) != hipSuccess || hipDeviceGetAttribute(&cus, hipDeviceAttributeMultiprocessorCount, dev) != hipSuccess) { grid = -1; return; }
        if (hipFuncSetAttribute((const void*)fwd_kernel, hipFuncAttributeMaxDynamicSharedMemorySize, LDS_BYTES) != hipSuccess) { fprintf(stderr, "kernel_launch: hipFuncSetAttribute failed\n"); grid = -1; return; }
        if (hipOccupancyMaxActiveBlocksPerMultiprocessor(&per_cu, (const void*)fwd_kernel, 512, LDS_BYTES) != hipSuccess || per_cu < 1) { fprintf(stderr, "kernel_launch: occupancy query gave %d\n", per_cu); per_cu = 1; }
        (void)hipGetLastError();
        grid = cus * per_cu;
    }
    if (grid < 0) return;
    (void)hipMemsetAsync((char*)d_ws + WS_CTL, 0, 2 * CTL_BYTES, stream);
    Params p{};
    for (int i = 0; i < 27; ++i) p.in[i] = (const float*)d_in[i];
    p.out = (float*)d_out; p.ws = (unsigned char*)d_ws;
    void* args[] = {&p};
    const hipError_t e = hipLaunchCooperativeKernel((const void*)fwd_kernel, dim3(grid), dim3(512), args, LDS_BYTES, stream);
    if (e != hipSuccess) fprintf(stderr, "kernel_launch: cooperative launch failed: %s (grid %d)\n", hipGetErrorString(e), grid);
}
```

```cpp
#include <hip/hip_runtime.h>
#include <hip/hip_cooperative_groups.h>
#include <cstdio>
#include <cstdint>
namespace cg = cooperative_groups;
namespace pg8 {
#define PG8_LAS __attribute__((address_space(3)))
typedef unsigned short bf16_t;
typedef short bf16x8 __attribute__((ext_vector_type(8)));
typedef float f32x4 __attribute__((ext_vector_type(4)));
typedef unsigned u32x4 __attribute__((ext_vector_type(4)));
constexpr int BM = 256, BK = 64, HALF = 128, HTB = HALF * BK * 2  , STAGE_BYTES = 8 * HTB, NXCD = 8, WGM = 8;

__host__ __device__ __forceinline__ int lds_byte(int r, int c) { const int st = (r >> 4) * 2 + (c >> 5), rr = r & 15, cc = c & 31, ob = rr * 64 + cc * 2; return st * 1024 + (ob ^ (((ob >> 9) & 1) << 5)); }
__host__ __device__ __forceinline__ void stage_rc(int b, int& R, int& C) { const int st = b / 1024, sb = b % 1024, swz = sb ^ (((sb >> 9) & 1) << 5); R = (st >> 1) * 16 + swz / 64; C = (st & 1) * 32 + (swz % 64) / 2; }
__host__ __device__ __forceinline__ int perm32(int rho) { const int n = rho >> 4, i = rho & 15; return 8 * (i >> 2) + 4 * n + (i & 3); }

struct Unit { int pm, pn; };
struct Gemm { const bf16_t* A; const bf16_t* Bt; int M, N, K, lda, ldb; };

struct StaticOrder {
    int nM, nN, nwg, G, c;
    __host__ __device__ void init(int M, int N, int G_, int c_) { nM = M / BM; nN = N / BM; nwg = nM * nN; G = G_; c = c_; }
    __host__ __device__ bool next(int i, Unit& u) const { return at((long)i * G + c, u); }
    __host__ __device__ bool at(long L, Unit& u) const {
        if (L >= nwg) return false;
        int wgid = (int)L; { const int q = nwg / NXCD, r = nwg % NXCD, xcd = wgid % NXCD, off = wgid / NXCD; wgid = (xcd < r ? xcd * (q + 1) : r * (q + 1) + (xcd - r) * q) + off; }
        const int nig = WGM * nN, gid = wgid / nig, fm = gid * WGM, gsz = (nM - fm) < WGM ? (nM - fm) : WGM;
        u.pm = fm + ((wgid % nig) % gsz); u.pn = (wgid % nig) / gsz; return true;
    }
    __device__ __forceinline__ void a_ready(const Unit&) const {}
    __device__ __forceinline__ void done(const Unit&) const {}
};


struct P1Order {
    StaticOrder so; int G, c;
    __host__ __device__ void init(int G_, int c_) { so.init(8192, 6144, G_, c_); G = G_; c = c_; }
    __host__ __device__ bool next(int i, Unit& u) const {
        const long L = (long)i * G + c; if (L < 768) return so.at(L, u);
        const int j = (int)(L - 768); if (j >= 32) return false; u.pm = 32 + (j & 3); u.pn = j >> 2; return true; }
    __device__ __forceinline__ void a_ready(const Unit&) const {}
    __device__ __forceinline__ void done(const Unit&) const {}
};

typedef float f32x2_t __attribute__((ext_vector_type(2))); typedef __bf16 bf16x2_t __attribute__((ext_vector_type(2)));
__device__ __forceinline__ unsigned cvtpk(float lo, float hi) { f32x2_t v = {lo, hi}; bf16x2_t b = __builtin_convertvector(v, bf16x2_t); return __builtin_bit_cast(unsigned, b); }
__device__ __forceinline__ u32x4 pack8(f32x4 a, f32x4 b) { u32x4 w; w.x = cvtpk(a[0], a[1]); w.y = cvtpk(a[2], a[3]); w.z = cvtpk(b[0], b[1]); w.w = cvtpk(b[2], b[3]); return w; }
__device__ __forceinline__ void unpack8(u32x4 w, f32x4& a, f32x4& b) {
    a[0] = __uint_as_float(w.x << 16); a[1] = __uint_as_float(w.x & 0xffff0000u); a[2] = __uint_as_float(w.y << 16); a[3] = __uint_as_float(w.y & 0xffff0000u);
    b[0] = __uint_as_float(w.z << 16); b[1] = __uint_as_float(w.z & 0xffff0000u); b[2] = __uint_as_float(w.w << 16); b[3] = __uint_as_float(w.w & 0xffff0000u); }
__device__ __forceinline__ float sigm(float x) { return __builtin_amdgcn_rcpf(1.f + __builtin_amdgcn_exp2f(-1.4426950408889634f * x)); }
__device__ __forceinline__ f32x4 sigm4(f32x4 v) { f32x4 o; o[0] = sigm(v[0]); o[1] = sigm(v[1]); o[2] = sigm(v[2]); o[3] = sigm(v[3]); return o; }
__device__ __forceinline__ float rowred(float s) { s += __shfl_xor(s, 16); s += __shfl_xor(s, 32); return s; }
__device__ __forceinline__ float dot4(f32x4 x) { return (x[0] * x[0] + x[1] * x[1]) + (x[2] * x[2] + x[3] * x[3]); }
__device__ __forceinline__ void rope4(f32x4& v0, f32x4& v1, int pos, int fq) {
#pragma unroll
    for (int i = 0; i < 4; ++i) { const float f = (float)(4 * fq + i); const float inv = __builtin_amdgcn_exp2f(-f * 0.8304820237218406f);
        const float rev = (float)pos * inv * 0.15915494309189535f; const float c = __builtin_amdgcn_cosf(rev), s = __builtin_amdgcn_sinf(rev);
        const float a = v0[i], b = v1[i]; v0[i] = a * c - b * s; v1[i] = b * c + a * s; }
}
#define LDNT4(p) __builtin_nontemporal_load((const f32x4*)(p))
#define LDNT16(p) __builtin_nontemporal_load((const u32x4*)(p))
#define EPI_ARGS f32x4 (&acc)[2][2][4][2], const Unit& u, int wr, int wc, int fr, int fq
#define EPI_ROWS _Pragma("unroll") for (int ai = 0; ai < 2; ++ai) _Pragma("unroll") for (int m = 0; m < 4; ++m)
constexpr float EPSN = 1e-6f;

struct EpiIn { static constexpr bool PERM = true, AFTER_DRAIN = false;
    bf16_t *U, *CQKV, *KR, *GATES; float *ssq_q, *ssq_kv;
    __device__ __forceinline__ void operator()(EPI_ARGS) const {
        const int pn = u.pn, row0 = u.pm * BM + wr * 64 + fr, cl = wc * 32 + 8 * fq;
        if (pn < 4) {
            EPI_ROWS { const int row = row0 + ai * HALF + m * 16;
#pragma unroll
                for (int bj = 0; bj < 2; ++bj) *(u32x4*)(U + (size_t)row * 1024 + pn * 256 + bj * HALF + cl) = pack8(acc[ai][bj][m][0], acc[ai][bj][m][1]); }
        } else if (pn < 7) {
            float* ssq = pn < 6 ? ssq_q : ssq_kv;
            EPI_ROWS { const int row = row0 + ai * HALF + m * 16; float s = 0.f;
#pragma unroll
                for (int bj = 0; bj < 2; ++bj) { s += dot4(acc[ai][bj][m][0]) + dot4(acc[ai][bj][m][1]);
                    *(u32x4*)(CQKV + (size_t)row * 768 + (pn - 4) * 256 + bj * HALF + cl) = pack8(acc[ai][bj][m][0], acc[ai][bj][m][1]); }
                s = rowred(s); if (fq == 0) atomicAdd(ssq + row, s); }
        } else if (pn == 7) {
            if (wc < 2) {
                EPI_ROWS { const int row = row0 + ai * HALF + m * 16; f32x4 v0 = acc[ai][0][m][0], v1 = acc[ai][0][m][1];
                    if (u.pm < 32) { const int l = row & 2047; rope4(v0, v1, wc == 0 ? (l >> 6) : (l & 63), fq); }
                    *(u32x4*)(KR + (size_t)row * 64 + cl) = pack8(v0, v1); }
            }
        } else if (u.pm < 32) {
            EPI_ROWS { const int row = row0 + ai * HALF + m * 16;
#pragma unroll
                for (int bj = 0; bj < 2; ++bj) *(u32x4*)(GATES + (size_t)row * 4096 + (pn - 8) * 256 + bj * HALF + cl) = pack8(sigm4(acc[ai][bj][m][0]), sigm4(acc[ai][bj][m][1])); }
        }
    }
};
struct EpiQ { static constexpr bool PERM = true, AFTER_DRAIN = false;
    bf16_t* Q; const float* ssq_q;
    __device__ __forceinline__ void operator()(EPI_ARGS) const {
        const int row0 = u.pm * BM + wr * 64 + fr;
        EPI_ROWS { const int row = row0 + ai * HALF + m * 16; const float rstd = __builtin_amdgcn_rsqf(ssq_q[row] * (1.f / 512.f) + EPSN); const int l = row & 2047;
#pragma unroll
            for (int bj = 0; bj < 2; ++bj) { const int colg = u.pn * BM + bj * HALF + wc * 32, off = colg % 192; f32x4 v0 = acc[ai][bj][m][0] * rstd, v1 = acc[ai][bj][m][1] * rstd;
                if (off >= 128) rope4(v0, v1, off < 160 ? (l >> 6) : (l & 63), fq);
                *(u32x4*)(Q + (size_t)row * 1536 + colg + 8 * fq) = pack8(v0, v1); } }
    }
};
struct EpiKV { static constexpr bool PERM = true, AFTER_DRAIN = false;
    bf16_t *KN, *V; const float* ssq_kv;
    __device__ __forceinline__ void operator()(EPI_ARGS) const {
        const int row0 = u.pm * BM + wr * 64 + fr, cl = wc * 32 + 8 * fq;
        EPI_ROWS { const int row = row0 + ai * HALF + m * 16; const float rstd = __builtin_amdgcn_rsqf(ssq_kv[row] * (1.f / 256.f) + EPSN);
            *(u32x4*)(KN + (size_t)row * 1024 + u.pn * 128 + cl) = pack8(acc[ai][0][m][0] * rstd, acc[ai][0][m][1] * rstd);
            *(u32x4*)(V + (size_t)row * 1024 + u.pn * 128 + cl) = pack8(acc[ai][1][m][0] * rstd, acc[ai][1][m][1] * rstd); }
    }
};
struct EpiGlu { static constexpr bool PERM = true, AFTER_DRAIN = false;
    bf16_t* S5P; const bf16_t* GATES;
    __device__ __forceinline__ void operator()(EPI_ARGS) const {
        const int row0 = u.pm * BM + wr * 64 + fr, c = u.pn * 128 + wc * 32 + 8 * fq;
        EPI_ROWS { const int row = row0 + ai * HALF + m * 16; f32x4 g0, g1; unpack8(LDNT16(GATES + (size_t)row * 4096 + c), g0, g1);
            *(u32x4*)(S5P + (size_t)row * 2048 + c) = pack8(g0 * acc[ai][0][m][0] * sigm4(acc[ai][1][m][0]), g1 * acc[ai][0][m][1] * sigm4(acc[ai][1][m][1])); }
    }
};
struct EpiMix { static constexpr bool PERM = true, AFTER_DRAIN = false;
    const bf16_t *S5P, *GATES; bf16_t* MIX;
    __device__ __forceinline__ void operator()(EPI_ARGS) const {
        const int row0 = u.pm * BM + wr * 64 + fr;
        EPI_ROWS { const int row = row0 + ai * HALF + m * 16;
#pragma unroll
            for (int bj = 0; bj < 2; ++bj) { const int c = u.pn * BM + bj * HALF + wc * 32 + 8 * fq; f32x4 g0, g1, s0, s1;
                unpack8(LDNT16(GATES + (size_t)row * 4096 + 2048 + c), g0, g1); unpack8(LDNT16(S5P + (size_t)row * 2048 + c), s0, s1);
                *(u32x4*)(MIX + (size_t)row * 2048 + c) = pack8(s0 + g0 * acc[ai][bj][m][0], s1 + g1 * acc[ai][bj][m][1]); } }
    }
};
struct EpiOut { static constexpr bool PERM = true, AFTER_DRAIN = false;
    const float *x, *MOD, *norm2; float *X1, *ssq; bf16_t* X1S;
    __device__ __forceinline__ void operator()(EPI_ARGS) const {
        const int row0 = u.pm * BM + wr * 64 + fr; const float* mod = MOD + (size_t)(u.pm >> 3) * 12288;
        EPI_ROWS { const int row = row0 + ai * HALF + m * 16; float s = 0.f;
#pragma unroll
            for (int bj = 0; bj < 2; ++bj) { const int c = u.pn * BM + bj * HALF + wc * 32 + 8 * fq; const size_t o = (size_t)row * 2048 + c;
                f32x4 x1v[2];
#pragma unroll
                for (int n = 0; n < 2; ++n) { const f32x4 g1 = *(const f32x4*)(mod + 2 * 2048 + c + 4 * n), xv = LDNT4(x + o + 4 * n);
                    x1v[n] = xv + g1 * acc[ai][bj][m][n]; *(f32x4*)(X1 + o + 4 * n) = x1v[n]; s += dot4(x1v[n]); }
                const f32x4 sa = *(const f32x4*)(norm2 + c) * (*(const f32x4*)(mod + 4 * 2048 + c) + 1.f), sb = *(const f32x4*)(norm2 + c + 4) * (*(const f32x4*)(mod + 4 * 2048 + c + 4) + 1.f);
                *(u32x4*)(X1S + o) = pack8(x1v[0] * sa, x1v[1] * sb); }
            s = rowred(s); if (fq == 0) atomicAdd(ssq + row, s); }
    }
};
struct EpiFfn1 { static constexpr bool PERM = true, AFTER_DRAIN = false;
    const float *ssq, *BIAS2; bf16_t* ACT;
    __device__ __forceinline__ void operator()(EPI_ARGS) const {
        const int row0 = u.pm * BM + wr * 64 + fr, cb = u.pn * BM + wc * 32 + 8 * fq; const float* bias = BIAS2 + (size_t)(u.pm >> 3) * 11264 + cb;
        const f32x4 ba0 = *(const f32x4*)(bias), ba1 = *(const f32x4*)(bias + 4), bb0 = *(const f32x4*)(bias + HALF), bb1 = *(const f32x4*)(bias + HALF + 4);
        EPI_ROWS { const int row = row0 + ai * HALF + m * 16; const float rstd = __builtin_amdgcn_rsqf(ssq[row] * (1.f / 2048.f) + EPSN);
            const f32x4 a0 = acc[ai][0][m][0] * rstd + ba0, a1 = acc[ai][0][m][1] * rstd + ba1, b0 = acc[ai][1][m][0] * rstd + bb0, b1 = acc[ai][1][m][1] * rstd + bb1;
            *(u32x4*)(ACT + (size_t)row * 5632 + u.pn * 128 + wc * 32 + 8 * fq) = pack8(a0 * sigm4(a0) * b0, a1 * sigm4(a1) * b1); }
    }
};
struct EpiFfn2 { static constexpr bool PERM = true, AFTER_DRAIN = false;
    const float *X1, *MOD, *normf; float *out, *ssq; unsigned* cnt; int fuse;
    __device__ __forceinline__ void operator()(EPI_ARGS) const {
        const int row0 = u.pm * BM + wr * 64 + fr; const float* mod = MOD + (size_t)(u.pm >> 3) * 12288 + 5 * 2048;
        EPI_ROWS { const int row = row0 + ai * HALF + m * 16; float s = 0.f;
#pragma unroll
            for (int bj = 0; bj < 2; ++bj) { const int c = u.pn * BM + bj * HALF + wc * 32 + 8 * fq; const size_t o = (size_t)row * 2048 + c;
#pragma unroll
                for (int n = 0; n < 2; ++n) { const f32x4 x2 = LDNT4(X1 + o + 4 * n) + *(const f32x4*)(mod + c + 4 * n) * acc[ai][bj][m][n]; acc[ai][bj][m][n] = x2; if (!fuse) *(f32x4*)(out + o + 4 * n) = x2; s += dot4(x2); } }
            s = rowred(s); if (fq == 0) atomicAdd(ssq + row, s); }
        if (!fuse) return;
        asm volatile("s_waitcnt vmcnt(0)" ::: "memory");
        unsigned* pc = cnt + 64 * u.pm;
        if ((threadIdx.x & 63) == 0) __hip_atomic_fetch_add(pc, 1u, __ATOMIC_RELAXED, __HIP_MEMORY_SCOPE_AGENT);
        if (threadIdx.x < 64) { unsigned sp = 0; while ((unsigned)__builtin_amdgcn_readfirstlane(__hip_atomic_load(pc, __ATOMIC_RELAXED, __HIP_MEMORY_SCOPE_AGENT)) < 64u) { __builtin_amdgcn_s_sleep(2); if (++sp > (1u << 20)) break; } }
        __builtin_amdgcn_fence(__ATOMIC_ACQUIRE, "agent");
        __syncthreads();
        EPI_ROWS { const int row = row0 + ai * HALF + m * 16; const float rstd = __builtin_amdgcn_rsqf(__hip_atomic_load(ssq + row, __ATOMIC_RELAXED, __HIP_MEMORY_SCOPE_AGENT) * (1.f / 2048.f) + EPSN);
#pragma unroll
            for (int bj = 0; bj < 2; ++bj) { const int c = u.pn * BM + bj * HALF + wc * 32 + 8 * fq; const size_t o = (size_t)row * 2048 + c;
#pragma unroll
                for (int n = 0; n < 2; ++n) *(f32x4*)(out + o + 4 * n) = acc[ai][bj][m][n] * rstd * *(const f32x4*)(normf + c + 4 * n); } }
    }
};

template <class Epi, class Sched, bool ALIGN_EPI = false, bool SP2 = false>
__device__ __forceinline__ void gemm_phase(PG8_LAS unsigned char* lds, const Gemm g, const Sched& S, const Epi& E) {
    int tid_o = threadIdx.x; asm volatile("" : "+v"(tid_o));
    const int tid = tid_o, wid = __builtin_amdgcn_readfirstlane(tid >> 6), lane = tid & 63, wr = wid >> 2, wc = wid & 3, fr = lane & 15, fq = lane >> 4;
    const int K = g.K, nt = K / BK;
    unsigned voffA[2], voffB[2];
#pragma unroll
    for (int i = 0; i < 2; ++i) { int R, C; stage_rc(tid * 16 + i * 8192, R, C); const int Rb = Epi::PERM ? ((R & ~31) + perm32(R & 31)) : R;
        voffA[i] = (unsigned)(R * g.lda + C) * 2u; voffB[i] = (unsigned)(Rb * g.ldb + C) * 2u; }
    const size_t kstep = (size_t)(BK * 2);
    const size_t hstepA = (size_t)HALF * g.lda * 2, hstepB = (size_t)HALF * g.ldb * 2;
    const size_t tstepA = 2 * hstepA, tstepB = 2 * hstepB;
    const unsigned ldsw = (unsigned)wid * 1024u;
    const int aoff = lds_byte(wr * 64 + fr, fq * 8), boff = lds_byte(wc * 32 + fr, fq * 8);
#define PG8_SA(b, h) (((b) * 2 + (h)) * HTB)
#define PG8_SB(b, h) ((4 + (b) * 2 + (h)) * HTB)
#define PG8_STAGE(bufoff, gbase, voff) do { _Pragma("unroll") for (int _i = 0; _i < 2; ++_i) \
        __builtin_amdgcn_global_load_lds((const unsigned*)((const char*)(gbase) + (voff)[_i]), (PG8_LAS unsigned*)(lds + (bufoff) + ldsw + _i * 8192), 16, 0, 0); } while (0)
#define PG8_LDA(dst, b, h) do { _Pragma("unroll") for (int m = 0; m < 4; ++m) _Pragma("unroll") for (int k = 0; k < 2; ++k) dst[m][k] = *(const PG8_LAS bf16x8*)(lds + PG8_SA(b, h) + aoff + m * 2048 + k * 1024); } while (0)
#define PG8_LDB(dst, b, h) do { _Pragma("unroll") for (int n = 0; n < 2; ++n) _Pragma("unroll") for (int k = 0; k < 2; ++k) dst[n][k] = *(const PG8_LAS bf16x8*)(lds + PG8_SB(b, h) + boff + n * 2048 + k * 1024); } while (0)
#define PG8_MMA(ai, bj, At, Bt) do { __builtin_amdgcn_s_setprio(1); _Pragma("unroll") for (int m = 0; m < 4; ++m) _Pragma("unroll") for (int n = 0; n < 2; ++n) _Pragma("unroll") for (int k = 0; k < 2; ++k) \
        acc[ai][bj][m][n] = __builtin_amdgcn_mfma_f32_16x16x32_bf16(Bt[n][k], At[m][k], acc[ai][bj][m][n], 0, 0, 0); __builtin_amdgcn_s_setprio(0); } while (0)
#define PG8_WAIT_V(n) asm volatile("s_waitcnt vmcnt(" #n ")" ::: "memory")
#define PG8_WAIT_L(n) asm volatile("s_waitcnt lgkmcnt(" #n ")" ::: "memory")
#define PG8_BAR __builtin_amdgcn_s_barrier()
#define PG8_SCHED __builtin_amdgcn_sched_barrier(0)
    Unit cur, nxt; int ui = 0;
    if (!S.next(0, cur)) return;
    f32x4 acc[2][2][4][2];
#pragma unroll
    for (int a = 0; a < 2; ++a)
#pragma unroll
        for (int b = 0; b < 2; ++b)
#pragma unroll
            for (int m = 0; m < 4; ++m)
#pragma unroll
                for (int n = 0; n < 2; ++n) acc[a][b][m][n] = (f32x4){0.f, 0.f, 0.f, 0.f};
    bf16x8 At[4][2], B0[2][2], B1[2][2];
    const char* cA = (const char*)g.A + (size_t)cur.pm * tstepA; const char* cB = (const char*)g.Bt + (size_t)cur.pn * tstepB;
    S.a_ready(cur);
    if constexpr (SP2) {
        PG8_STAGE(PG8_SB(0, 0), cB, voffB); PG8_STAGE(PG8_SB(0, 1), cB + hstepB, voffB); PG8_STAGE(PG8_SA(0, 0), cA, voffA); PG8_STAGE(PG8_SA(0, 1), cA + hstepA, voffA);
        if (wr == 1) PG8_BAR;
        PG8_WAIT_V(2); PG8_BAR;
        PG8_STAGE(PG8_SB(1, 0), cB + kstep, voffB); PG8_STAGE(PG8_SA(1, 0), cA + kstep, voffA); PG8_STAGE(PG8_SB(1, 1), cB + hstepB + kstep, voffB);
        PG8_WAIT_V(6); PG8_BAR;
    } else {
        PG8_STAGE(PG8_SB(0, 0), cB, voffB); PG8_STAGE(PG8_SA(0, 0), cA, voffA); PG8_STAGE(PG8_SB(0, 1), cB + hstepB, voffB); PG8_STAGE(PG8_SA(0, 1), cA + hstepA, voffA);
        if (wr == 1) PG8_BAR;
        PG8_WAIT_V(4); PG8_BAR;
        PG8_STAGE(PG8_SB(1, 0), cB + kstep, voffB); PG8_STAGE(PG8_SA(1, 0), cA + kstep, voffA); PG8_STAGE(PG8_SB(1, 1), cB + hstepB + kstep, voffB);
        PG8_WAIT_V(6); PG8_BAR;
    }
    for (;;) {
        const bool has_next = S.next(ui + 1, nxt);
        const char* nA = has_next ? (const char*)g.A + (size_t)nxt.pm * tstepA : cA; const char* nB = has_next ? (const char*)g.Bt + (size_t)nxt.pn * tstepB : cB;
        for (int t = 0; t < nt; t += 2) {
            const bool last = (t == nt - 2);
            const char* a1 = cA + (size_t)(t + 1) * kstep;
            const char* a2 = last ? nA : cA + (size_t)(t + 2) * kstep; const char* b2 = last ? nB : cB + (size_t)(t + 2) * kstep;
            const char* a3 = a2 + kstep; const char* b3 = b2 + kstep;
            if (last && has_next) S.a_ready(nxt);
            if constexpr (SP2) {
            PG8_LDB(B0, 0, 0); PG8_LDB(B1, 0, 1); PG8_SCHED; PG8_LDA(At, 0, 0); PG8_STAGE(PG8_SA(1, 1), a1 + hstepA, voffA);
            PG8_WAIT_V(8); PG8_WAIT_L(0); PG8_BAR; PG8_MMA(0, 0, At, B0); PG8_MMA(0, 1, At, B1); PG8_BAR; PG8_SCHED;
            PG8_LDA(At, 0, 1); PG8_STAGE(PG8_SB(0, 0), b2, voffB); PG8_STAGE(PG8_SB(0, 1), b2 + hstepB, voffB); PG8_STAGE(PG8_SA(0, 0), a2, voffA);
            PG8_WAIT_V(8); PG8_WAIT_L(0); PG8_BAR; PG8_MMA(1, 0, At, B0); PG8_MMA(1, 1, At, B1); PG8_BAR; PG8_SCHED;
            PG8_LDB(B0, 1, 0); PG8_LDB(B1, 1, 1); PG8_SCHED; PG8_LDA(At, 1, 0); PG8_STAGE(PG8_SA(0, 1), a2 + hstepA, voffA);
            PG8_WAIT_V(8); PG8_WAIT_L(0); PG8_BAR; PG8_MMA(0, 0, At, B0); PG8_MMA(0, 1, At, B1); PG8_BAR; PG8_SCHED;
            PG8_LDA(At, 1, 1); PG8_STAGE(PG8_SB(1, 0), b3, voffB); PG8_STAGE(PG8_SB(1, 1), b3 + hstepB, voffB); PG8_STAGE(PG8_SA(1, 0), a3, voffA);
            PG8_WAIT_V(8); PG8_WAIT_L(0); PG8_BAR; PG8_MMA(1, 0, At, B0); PG8_MMA(1, 1, At, B1); PG8_BAR; PG8_SCHED;
            } else {
            PG8_LDB(B0, 0, 0); PG8_SCHED; PG8_LDA(At, 0, 0); PG8_STAGE(PG8_SA(1, 1), a1 + hstepA, voffA);
            PG8_WAIT_L(8); PG8_BAR; PG8_WAIT_L(0); PG8_MMA(0, 0, At, B0); PG8_BAR; PG8_SCHED;
            PG8_LDB(B1, 0, 1); PG8_STAGE(PG8_SB(0, 0), b2, voffB);
            PG8_BAR; PG8_WAIT_L(0); PG8_MMA(0, 1, At, B1); PG8_BAR;
            PG8_LDA(At, 0, 1); PG8_STAGE(PG8_SA(0, 0), a2, voffA);
            PG8_BAR; PG8_WAIT_L(0); PG8_MMA(1, 0, At, B0); PG8_BAR; PG8_SCHED;
            PG8_STAGE(PG8_SB(0, 1), b2 + hstepB, voffB);
            PG8_WAIT_V(6); PG8_BAR; PG8_MMA(1, 1, At, B1); PG8_BAR;
            PG8_LDB(B0, 1, 0); PG8_SCHED; PG8_LDA(At, 1, 0); PG8_STAGE(PG8_SA(0, 1), a2 + hstepA, voffA);
            PG8_WAIT_L(8); PG8_BAR; PG8_WAIT_L(0); PG8_MMA(0, 0, At, B0); PG8_BAR; PG8_SCHED;
            PG8_LDB(B1, 1, 1); PG8_STAGE(PG8_SB(1, 0), b3, voffB);
            PG8_BAR; PG8_WAIT_L(0); PG8_MMA(0, 1, At, B1); PG8_BAR;
            PG8_LDA(At, 1, 1); PG8_STAGE(PG8_SA(1, 0), a3, voffA);
            PG8_BAR; PG8_WAIT_L(0); PG8_MMA(1, 0, At, B0); PG8_BAR; PG8_SCHED;
            PG8_STAGE(PG8_SB(1, 1), b3 + hstepB, voffB);
            PG8_WAIT_V(6); PG8_BAR; PG8_MMA(1, 1, At, B1); PG8_BAR;
            }
        }
        if constexpr (ALIGN_EPI) { if (wr == 0) PG8_BAR; }
        if constexpr (!Epi::AFTER_DRAIN) { E(acc, cur, wr, wc, fr, fq); S.done(cur); }
        if (!has_next) break;
#pragma unroll
        for (int a = 0; a < 2; ++a)
#pragma unroll
            for (int b = 0; b < 2; ++b)
#pragma unroll
                for (int m = 0; m < 4; ++m)
#pragma unroll
                    for (int n = 0; n < 2; ++n) acc[a][b][m][n] = (f32x4){0.f, 0.f, 0.f, 0.f};
        cur = nxt; cA = nA; cB = nB; ++ui;
        if constexpr (ALIGN_EPI) { if (wr == 1) PG8_BAR; }
    }
    PG8_WAIT_V(0);
    if constexpr (!ALIGN_EPI) { if (wr == 0) PG8_BAR; }
    PG8_BAR;
    if constexpr (Epi::AFTER_DRAIN) { E.fused(acc, cur, wr, wc, fr, fq, lds, wid, lane); S.done(cur); }
#undef PG8_SA
#undef PG8_SB
#undef PG8_STAGE
#undef PG8_LDA
#undef PG8_LDB
#undef PG8_MMA
#undef PG8_WAIT_V
#undef PG8_WAIT_L
#undef PG8_BAR
#undef PG8_SCHED
}
}


#define LAS __attribute__((address_space(3)))
typedef unsigned short bf16_t;
typedef short bf16x8 __attribute__((ext_vector_type(8)));
typedef short s16x4 __attribute__((ext_vector_type(4)));
typedef float f32x4 __attribute__((ext_vector_type(4)));
typedef float f32x16 __attribute__((ext_vector_type(16)));
typedef unsigned u32x4 __attribute__((ext_vector_type(4)));
typedef unsigned u32x2 __attribute__((ext_vector_type(2)));
using pg8::cvtpk; using pg8::pack8; using pg8::unpack8; using pg8::sigm; using pg8::dot4;
#define LDS_WAIT() asm volatile("s_waitcnt lgkmcnt(0)" ::: "memory")
__device__ __forceinline__ int opaque_tid() { int t = threadIdx.x; asm volatile("" : "+v"(t)); return t; }

constexpr size_t MiB = 1u << 20;
constexpr size_t WS_CTL = 0, CTL_BYTES = 1 * MiB;
constexpr size_t WS_MOD = 1 * MiB, WS_BIAS2 = 1 * MiB + 512 * 1024;
constexpr size_t WS_WIN = 2 * MiB, WS_WGLU = 26 * MiB, WS_WUQ = 34 * MiB, WS_WUKV = 36 * MiB, WS_WMO = 38 * MiB, WS_WOUT = 42 * MiB, WS_WF1 = 50 * MiB, WS_WF2 = 94 * MiB;
constexpr size_t WS_GATES = 116 * MiB, WS_XMOD = 180 * MiB, WS_U = 216 * MiB, WS_CQKV = 234 * MiB, WS_KR = 248 * MiB, WS_KCOMB = 250 * MiB, WS_WTAB = 252 * MiB, WS_VTAB = 268 * MiB;
constexpr size_t WS_Q = 284 * MiB, WS_KN = 308 * MiB, WS_V = 326 * MiB, WS_Z = 344 * MiB;
constexpr size_t WS_O = 180 * MiB, WS_S5P = 216 * MiB, WS_MIX = 252 * MiB, WS_X1 = 284 * MiB, WS_X1S = 204 * MiB, WS_ACT = 116 * MiB;
constexpr size_t WS_END = 360 * MiB;
constexpr int SSQ_Q = 0, SSQ_KV = 16384, SSQ_1 = 32768, SSQ_2 = 49152;
constexpr int LDS_BYTES = 147456;

struct Params { const float* in[27]; float* out; unsigned char* ws; };
enum { I_X = 0, I_C, I_CTX, I_CCTX, I_WMOD, I_BMOD, I_NORM1, I_NORM2, I_WIN, I_ARE, I_AIM, I_LOGDT, I_BRE, I_BIM, I_CRE, I_CIM, I_D, I_WGLU, I_QNORM, I_KVNORM, I_WUQ, I_WUKV, I_WMO, I_WOUT, I_WF1, I_WF2, I_NORMF };

__device__ __forceinline__ float wave_sum(float v) {
#pragma unroll
    for (int o = 1; o < 64; o <<= 1) v += __shfl_xor(v, o);
    return v;
}
__device__ __forceinline__ float dot4m(f32x4 a, f32x4 b) { return (a[0] * b[0] + a[1] * b[1]) + (a[2] * b[2] + a[3] * b[3]); }
__device__ __forceinline__ float bf2f(unsigned short u) { return __uint_as_float((unsigned)u << 16); }

struct TrItem { const float* W; const float* kscale; bf16_t* WT; const float* bias_sh; float* bias_out; int N, k0, n0, ldt, drow0; bool rperm, nt; };
__device__ __forceinline__ void tr_load(f32x4 (&v)[16], const TrItem& t, int lane) {
    const int r4 = lane >> 4, c4 = lane & 15;
#pragma unroll
    for (int i = 0; i < 16; ++i) v[i] = __builtin_nontemporal_load((const f32x4*)(t.W + (size_t)(t.k0 + r4 + 4 * i) * t.N + t.n0 + 4 * c4));
}
__device__ __forceinline__ void tr_finish(const f32x4 (&v)[16], const TrItem& t, LAS float* scr, int lane) {
    const int r4 = lane >> 4, c4 = lane & 15;
#pragma unroll
    for (int i = 0; i < 16; ++i) { const int kk = r4 + 4 * i; f32x4 w = v[i]; if (t.kscale) w = w * t.kscale[t.k0 + kk]; LAS float* d = scr + kk * 65 + 4 * c4; d[0] = w[0]; d[1] = w[1]; d[2] = w[2]; d[3] = w[3]; }
    LDS_WAIT();
    if (t.bias_out) {
        float a0 = 0.f, a1 = 0.f, a2 = 0.f, a3 = 0.f; const float* sh = t.bias_sh + t.k0;
#pragma unroll 1
        for (int k4 = 0; k4 < 64; k4 += 4) { const f32x4 s0 = *(const f32x4*)(sh + k4), s1 = *(const f32x4*)(sh + 12288 + k4), s2 = *(const f32x4*)(sh + 2 * 12288 + k4), s3 = *(const f32x4*)(sh + 3 * 12288 + k4);
#pragma unroll
            for (int e = 0; e < 4; ++e) { const float w = scr[(k4 + e) * 65 + lane]; a0 += w * s0[e]; a1 += w * s1[e]; a2 += w * s2[e]; a3 += w * s3[e]; } }
        atomicAdd(t.bias_out + lane, a0); atomicAdd(t.bias_out + 11264 + lane, a1); atomicAdd(t.bias_out + 2 * 11264 + lane, a2); atomicAdd(t.bias_out + 3 * 11264 + lane, a3);
    }
    const int c = lane & 7;
#pragma unroll
    for (int j = 0; j < 8; ++j) { const int n = (lane >> 3) + 8 * j; const int sn = t.rperm ? ((n & 32) | (((n >> 2) & 1) * 16 + ((n >> 3) & 3) * 4 + (n & 3))) : n;
        const LAS float* s = scr + (8 * c) * 65 + sn;
        u32x4 o; o.x = cvtpk(s[0], s[65]); o.y = cvtpk(s[130], s[195]); o.z = cvtpk(s[260], s[325]); o.w = cvtpk(s[390], s[455]);
        u32x4* dp = (u32x4*)(t.WT + (size_t)(t.drow0 + n) * t.ldt + t.k0 + 8 * c); if (t.nt) __builtin_nontemporal_store(o, dp); else *dp = o; }
    LDS_WAIT();
}
#define TR_LOOP(DECODE, FIRST, COUNT, STRIDE) do { int it_ = (FIRST); f32x4 va_[16], vb_[16]; TrItem ta_, tb_; \
    if (it_ < (COUNT)) { ta_ = DECODE(it_); tr_load(va_, ta_, lane); } \
    while (it_ < (COUNT)) { int nx_ = it_ + (STRIDE); if (nx_ < (COUNT)) { tb_ = DECODE(nx_); tr_load(vb_, tb_, lane); } tr_finish(va_, ta_, scr, lane); it_ = nx_; if (it_ >= (COUNT)) break; \
        nx_ = it_ + (STRIDE); if (nx_ < (COUNT)) { ta_ = DECODE(nx_); tr_load(va_, ta_, lane); } tr_finish(vb_, tb_, scr, lane); it_ = nx_; } } while (0)
struct Cx { float re, im; };
__device__ __forceinline__ Cx cmul(Cx a, Cx b) { Cx r; r.re = a.re * b.re - a.im * b.im; r.im = a.re * b.im + a.im * b.re; return r; }
__device__ __forceinline__ Cx cpowk(float lr, float li, float dt, float k) {
    const float mag = __builtin_amdgcn_exp2f(k * lr * dt * 1.4426950408889634f);
    float rev = k * (li * dt * 0.15915494309189535f); rev -= floorf(rev);
    Cx r; r.re = mag * __builtin_amdgcn_cosf(rev); r.im = mag * __builtin_amdgcn_sinf(rev); return r; }
__device__ __forceinline__ Cx s5_coef(float lr, float li, float dt) {
    const Cx ab = cpowk(lr, li, dt, 1.f); const float den = lr * lr + li * li, nr = ab.re - 1.f, ni = ab.im;
    Cx r; r.re = (nr * lr + ni * li) / den; r.im = (ni * lr - nr * li) / den; return r; }

#define XB_TMO      128
#define XB_XCNT(j)  (256  + 64 * (j))
#define XB_XSUB(j)  (1280 + 64 * (j))
#define XB_XGEN(j)  (2304 + 64 * (j))
#define XB_TOP      3328
#define XB_TOPGEN   3392
#define XCD_BAR_WORDS 3456
#define XB_SPIN_CAP (1u << 18)

__device__ __forceinline__ unsigned xb_ld(unsigned* p)              { return __hip_atomic_load(p, __ATOMIC_RELAXED, __HIP_MEMORY_SCOPE_AGENT); }
__device__ __forceinline__ unsigned xb_add(unsigned* p, unsigned v) { return __hip_atomic_fetch_add(p, v, __ATOMIC_RELAXED, __HIP_MEMORY_SCOPE_AGENT); }
__device__ __forceinline__ unsigned xb_xcc_id() { return (unsigned)__builtin_amdgcn_s_getreg((3 << 11) | 20) & 0xFu; }
#define XB_SPIN(cond, bar) do { unsigned _sp = 0; while (cond) { __builtin_amdgcn_s_sleep(1); \
    if ((++_sp & 255u) == 0u) { if (xb_ld(&(bar)[XB_TMO])) break; if (_sp > XB_SPIN_CAP) { atomicAdd(&(bar)[XB_TMO], 1u); break; } } } } while (0)

struct XcdBarrier {
    unsigned* bar; unsigned x;
    volatile LAS unsigned* st;
};

__device__ __forceinline__ XcdBarrier xcd_barrier_post(unsigned* bar, volatile LAS unsigned* st) {
    XcdBarrier b; b.bar = bar; b.x = xb_xcc_id(); b.st = st;
    if (threadIdx.x == 0) (void)xb_add(&bar[XB_XCNT(b.x)], 1u);
    return b;
}
__device__ __forceinline__ void xcd_barrier_complete(unsigned* bar, unsigned x, unsigned& nloc, unsigned& nx) {
    const unsigned G = gridDim.x * gridDim.y * gridDim.z;
    unsigned sum, cnt, mine, sp = 0u;
    for (;;) {
        sum = 0u; cnt = 0u; mine = 0u;
#pragma unroll
        for (unsigned j = 0; j < 16; ++j) { const unsigned c = xb_ld(&bar[XB_XCNT(j)]); sum += c; cnt += (c > 0u) ? 1u : 0u; mine = (j == x) ? c : mine; }
        if (sum == G) break;
        __builtin_amdgcn_s_sleep(1);
        if ((++sp & 255u) == 0u) { if (xb_ld(&bar[XB_TMO])) break; if (sp > XB_SPIN_CAP) { atomicAdd(&bar[XB_TMO], 1u); break; } }
    }
    nloc = mine > 0u ? mine : 1u; nx = cnt > 0u ? cnt : 1u;
}

__device__ __forceinline__ void xcd_barrier(const XcdBarrier& b) {
    asm volatile("s_waitcnt vmcnt(0)" ::: "memory");
    __syncthreads();
    if (threadIdx.x == 0) {
        unsigned* bar = b.bar;
        __builtin_amdgcn_s_waitcnt(0);
        unsigned nloc = b.st[0], nx = b.st[1];
        if (nloc == 0u) { xcd_barrier_complete(bar, b.x, nloc, nx); b.st[0] = nloc; b.st[1] = nx; }
        const unsigned old = xb_add(&bar[XB_XSUB(b.x)], 1u);
        const unsigned gen = old / nloc;
        if (old + 1u == (gen + 1u) * nloc) {
            __builtin_amdgcn_fence(__ATOMIC_RELEASE, "agent");
            asm volatile("s_waitcnt vmcnt(0)" ::: "memory");
            const unsigned og = xb_add(&bar[XB_TOP], 1u);
            const unsigned tg = og / nx;
            if (og + 1u == (tg + 1u) * nx) xb_add(&bar[XB_TOPGEN], 1u);
            else XB_SPIN(xb_ld(&bar[XB_TOPGEN]) == tg, bar);
            __builtin_amdgcn_fence(__ATOMIC_ACQUIRE, "agent");
            xb_add(&bar[XB_XGEN(b.x)], 1u);
            asm volatile("s_waitcnt vmcnt(0)" ::: "memory");
        } else {
            XB_SPIN(xb_ld(&bar[XB_XGEN(b.x)]) == gen, bar);
            __builtin_amdgcn_fence(__ATOMIC_ACQUIRE, "agent");
            asm volatile("s_waitcnt vmcnt(0)" ::: "memory");
        }
    }
    __syncthreads();
}


namespace att {
constexpr float SCALE = 0.07216878364870323f;
constexpr float THR = 8.f;
#define KSWZ(row, colB) ((row) * 256 + ((colB) ^ (((row) & 7) << 4)))
#define RSWZ(row, colB) ((row) * 128 + ((colB) ^ ((((row) >> 1) & 7) << 4)))
#define SBAR() __builtin_amdgcn_sched_barrier(0)
__device__ __forceinline__ int crow(int r, int hi) { return (r & 3) + 8 * (r >> 2) + 4 * hi; }
__device__ __forceinline__ void partialSM(f32x16& p0, f32x16& p1, float& m_reg, float& mn, float& alpha) {
  constexpr float C = SCALE * 1.4426950408889634f;
  float pmax = p0[0];
#pragma unroll
  for (int r = 1; r < 16; ++r) pmax = fmaxf(pmax, p0[r]);
#pragma unroll
  for (int r = 0; r < 16; ++r) pmax = fmaxf(pmax, p1[r]);
  { auto rr = __builtin_amdgcn_permlane32_swap(__float_as_uint(pmax), __float_as_uint(pmax), false, false);
    pmax = fmaxf(__uint_as_float(rr[0]), __uint_as_float(rr[1])); }
  if (__builtin_expect(__all(pmax - m_reg <= THR / SCALE), 1)) { mn = m_reg; alpha = 1.f; }
  else { mn = fmaxf(m_reg, pmax); alpha = __builtin_amdgcn_exp2f((m_reg - mn) * C); m_reg = mn; }
  const float mnC = -mn * C;
#pragma unroll
  for (int r = 0; r < 16; ++r) p0[r] = fmaf(p0[r], C, mnC);
#pragma unroll
  for (int r = 0; r < 16; ++r) p1[r] = fmaf(p1[r], C, mnC);
#pragma unroll
  for (int r = 0; r < 16; ++r) p0[r] = __builtin_amdgcn_exp2f(p0[r]);
}
__device__ __forceinline__ void finishSM(f32x16& p0, f32x16& p1, float alpha, float& l_reg, bf16x8& pa0, bf16x8& pa1, bf16x8& pa2, bf16x8& pa3) {
#pragma unroll
  for (int r = 0; r < 16; ++r) p1[r] = __builtin_amdgcn_exp2f(p1[r]);
  float ps = 0;
#pragma unroll
  for (int r = 0; r < 16; ++r) ps += p0[r];
#pragma unroll
  for (int r = 0; r < 16; ++r) ps += p1[r];
  { auto rr = __builtin_amdgcn_permlane32_swap(__float_as_uint(ps), __float_as_uint(ps), false, false);
    ps = __uint_as_float(rr[0]) + __uint_as_float(rr[1]); }
  l_reg = l_reg * alpha + ps;
#define PK4(P, BASE, OUT) do { unsigned a0 = cvtpk(P[BASE + 0], P[BASE + 1]), a1 = cvtpk(P[BASE + 2], P[BASE + 3]);   \
    unsigned b0 = cvtpk(P[BASE + 4], P[BASE + 5]), b1 = cvtpk(P[BASE + 6], P[BASE + 7]);                              \
    auto r0 = __builtin_amdgcn_permlane32_swap(a0, b0, false, false); auto r1 = __builtin_amdgcn_permlane32_swap(a1, b1, false, false); \
    u32x4 w = {r0[0], r1[0], r0[1], r1[1]}; OUT = __builtin_bit_cast(bf16x8, w); } while (0)
  PK4(p0, 0, pa0); PK4(p0, 8, pa1); PK4(p1, 0, pa2); PK4(p1, 8, pa3);
#undef PK4
}
__device__ __forceinline__ void qkt(f32x16& p0, f32x16& p1, const char* Ks, const char* Rs, const bf16x8* qr, int r32, int hi) {
  p0 = f32x16{}; p1 = f32x16{};
#pragma unroll
  for (int d0 = 0; d0 < 8; ++d0) { const int cb = (d0 * 16 + hi * 8) * 2;
    const bf16x8 b0 = *reinterpret_cast<const bf16x8*>(Ks + KSWZ(r32, cb));
    const bf16x8 b1 = *reinterpret_cast<const bf16x8*>(Ks + KSWZ(32 + r32, cb));
    p0 = __builtin_amdgcn_mfma_f32_32x32x16_bf16(b0, qr[d0], p0, 0, 0, 0);
    p1 = __builtin_amdgcn_mfma_f32_32x32x16_bf16(b1, qr[d0], p1, 0, 0, 0); }
#pragma unroll
  for (int d0 = 0; d0 < 4; ++d0) { const int cb = (d0 * 16 + hi * 8) * 2;
    const bf16x8 b0 = *reinterpret_cast<const bf16x8*>(Rs + RSWZ(r32, cb));
    const bf16x8 b1 = *reinterpret_cast<const bf16x8*>(Rs + RSWZ(32 + r32, cb));
    p0 = __builtin_amdgcn_mfma_f32_32x32x16_bf16(b0, qr[8 + d0], p0, 0, 0, 0);
    p1 = __builtin_amdgcn_mfma_f32_32x32x16_bf16(b1, qr[8 + d0], p1, 0, 0, 0); }
}
__device__ __forceinline__ int v_st(int k, int c) { const int kk = (k & ~0xC) | ((k & 4) << 1) | ((k & 8) >> 1); return ((kk >> 3) * 4 + (c >> 5)) * 512 + ((kk & 7) * 32 + (c & 31)) * 2; }
__device__ __forceinline__ int v_rd_base(int lane) { return ((lane & 3) << 3) | (((lane >> 2) & 3) << 6) | (((lane >> 4) & 1) << 5) | (((lane >> 5) & 1) << 8); }
constexpr int v_rd_off(int d0, int ks, int half) { return d0 * 512 + ks * 4096 + half * 2048; }
template <int OFF> __device__ __forceinline__ s16x4 tr_read(int vb) {
  s16x4 r; asm volatile("ds_read_b64_tr_b16 %0, %1 offset:%2" : "=&v"(r) : "v"(vb), "i"(OFF) : "memory"); return r;
}
template <int D0> __device__ __forceinline__ void pv_one(f32x16& od, int vb, bf16x8 pa0, bf16x8 pa1, bf16x8 pa2, bf16x8 pa3) {
  const s16x4 l0 = tr_read<v_rd_off(D0, 0, 0)>(vb), h0 = tr_read<v_rd_off(D0, 0, 1)>(vb), l1 = tr_read<v_rd_off(D0, 1, 0)>(vb), h1 = tr_read<v_rd_off(D0, 1, 1)>(vb);
  const s16x4 l2 = tr_read<v_rd_off(D0, 2, 0)>(vb), h2 = tr_read<v_rd_off(D0, 2, 1)>(vb), l3 = tr_read<v_rd_off(D0, 3, 0)>(vb), h3 = tr_read<v_rd_off(D0, 3, 1)>(vb);
  asm volatile("s_waitcnt lgkmcnt(0)" ::: "memory"); SBAR();
#define PK(L, H) (bf16x8){L[0], L[1], L[2], L[3], H[0], H[1], H[2], H[3]}
  od = __builtin_amdgcn_mfma_f32_32x32x16_bf16(pa0, PK(l0, h0), od, 0, 0, 0);
  od = __builtin_amdgcn_mfma_f32_32x32x16_bf16(pa1, PK(l1, h1), od, 0, 0, 0);
  od = __builtin_amdgcn_mfma_f32_32x32x16_bf16(pa2, PK(l2, h2), od, 0, 0, 0);
  od = __builtin_amdgcn_mfma_f32_32x32x16_bf16(pa3, PK(l3, h3), od, 0, 0, 0);
#undef PK
}
__device__ __forceinline__ void pv_d0(f32x16* o, int vb, bf16x8 pa0, bf16x8 pa1, bf16x8 pa2, bf16x8 pa3) {
  pv_one<0>(o[0], vb, pa0, pa1, pa2, pa3); pv_one<1>(o[1], vb, pa0, pa1, pa2, pa3); pv_one<2>(o[2], vb, pa0, pa1, pa2, pa3); pv_one<3>(o[3], vb, pa0, pa1, pa2, pa3);
}
#define GLDS16(gp, lp) __builtin_amdgcn_global_load_lds((const unsigned*)(gp), (LAS unsigned*)(lp), 16, 0, 0)
__device__ __forceinline__ void attn_unit(int b, int h, int qb, const bf16_t* __restrict__ Q, const bf16_t* __restrict__ KN, const bf16_t* __restrict__ KR, const bf16_t* __restrict__ V, bf16_t* __restrict__ O, char* lds, LAS unsigned char* L3) {
  const int tid = opaque_tid(), wid = __builtin_amdgcn_readfirstlane(tid >> 6), lane = tid & 63, r32 = lane & 31, hi = lane >> 5;
  char* K_lds = lds + 49152; char* R_lds = lds + 81920;
  float* ws = (float*)(lds + 98304) + wid * 64; float* li_l = ws; float* al_l = ws + 32;
  float m_reg = -1e30f, l_reg = 0; f32x16 o[4] = {}; bf16x8 qr[12];
  const size_t qrow0 = (size_t)b * 2048 + qb * 256 + wid * 32;
  const bf16_t* Qw = Q + (qrow0 + r32) * 1536 + h * 192 + hi * 8;
#pragma unroll
  for (int d0 = 0; d0 < 12; ++d0) qr[d0] = __builtin_nontemporal_load(reinterpret_cast<const bf16x8*>(Qw + d0 * 16));
  const int vb0 = (int)(uintptr_t)lds + v_rd_base(lane);
  int ko[2], vo[2], ro;
#pragma unroll
  for (int e = 0; e < 2; ++e) { const int q = wid * 2 + e; const int krow = 4 * q + (lane >> 4); ko[e] = krow * 1024 + h * 128 + (((lane & 15) ^ (krow & 7)) * 8);
    const int st = 2 * q + (lane >> 5), kk = (st >> 2) * 8 + ((lane >> 2) & 7), k = (kk & ~0xC) | ((kk & 4) << 1) | ((kk & 8) >> 1); vo[e] = k * 1024 + h * 128 + (st & 3) * 32 + (lane & 3) * 8; }
  { const int rrow = 8 * wid + (lane >> 3); ro = rrow * 64 + (((lane & 7) ^ ((rrow >> 1) & 7)) * 8); }
#define TROW(t) ((size_t)((t) < 32 ? b * 2048 + (t) * 64 : 8192 + b * 256 + ((t) - 32) * 64))
#define DMA(t, vbuf) do { const size_t r0_ = TROW(t); const bf16_t* kb_ = KN + r0_ * 1024; const bf16_t* vb_ = V + r0_ * 1024; const bf16_t* rb_ = KR + r0_ * 64; const int kb2_ = ((t) & 1); \
    GLDS16(kb_ + ko[0], L3 + 49152 + kb2_ * 16384 + (wid * 2) * 1024); GLDS16(kb_ + ko[1], L3 + 49152 + kb2_ * 16384 + (wid * 2 + 1) * 1024); \
    GLDS16(vb_ + vo[0], L3 + (vbuf) + (wid * 2) * 1024); GLDS16(vb_ + vo[1], L3 + (vbuf) + (wid * 2 + 1) * 1024); \
    GLDS16(rb_ + ro, L3 + 81920 + kb2_ * 8192 + wid * 1024); } while (0)
#define RESC(a) do { if (__any((a) < 1.f)) { if (hi == 0) al_l[r32] = (a); asm volatile("s_waitcnt lgkmcnt(0)" ::: "memory"); \
    _Pragma("unroll") for (int d = 0; d < 4; ++d) _Pragma("unroll") for (int r = 0; r < 16; ++r) o[d][r] *= al_l[crow(r, hi)]; } } while (0)
#define TOPBAR() do { asm volatile("s_waitcnt vmcnt(0)" ::: "memory"); __syncthreads(); } while (0)
#define VNEXT(x) ((x) == 32768 ? 0 : (x) + 16384)
  f32x16 pA0, pA1, pB0, pB1; float mnA, mnB, alA, alB; bf16x8 pa0, pa1, pa2, pa3; constexpr int NT = 36;
  int v_prev = 0, v_cur = 16384, v_nxt = 32768;
  DMA(0, 0); TOPBAR();
  DMA(1, 16384);
  qkt(pA0, pA1, K_lds, R_lds, qr, r32, hi); partialSM(pA0, pA1, m_reg, mnA, alA);
  for (int j = 1; j + 1 < NT; j += 2) {
    TOPBAR(); DMA(j + 1, v_nxt);
    SBAR(); qkt(pB0, pB1, K_lds + 16384, R_lds + 8192, qr, r32, hi);
    finishSM(pA0, pA1, alA, l_reg, pa0, pa1, pa2, pa3); SBAR();
    pv_d0(o, vb0 + v_prev, pa0, pa1, pa2, pa3); partialSM(pB0, pB1, m_reg, mnB, alB);
    RESC(alB);
    v_prev = v_cur; v_cur = v_nxt; v_nxt = VNEXT(v_nxt);
    TOPBAR(); if (j + 2 < NT) DMA(j + 2, v_nxt);
    SBAR(); qkt(pA0, pA1, K_lds, R_lds, qr, r32, hi);
    finishSM(pB0, pB1, alB, l_reg, pa0, pa1, pa2, pa3); SBAR();
    pv_d0(o, vb0 + v_prev, pa0, pa1, pa2, pa3); partialSM(pA0, pA1, m_reg, mnA, alA);
    RESC(alA);
    v_prev = v_cur; v_cur = v_nxt; v_nxt = VNEXT(v_nxt);
  }
  TOPBAR();
  SBAR(); qkt(pB0, pB1, K_lds + 16384, R_lds + 8192, qr, r32, hi);
  finishSM(pA0, pA1, alA, l_reg, pa0, pa1, pa2, pa3); SBAR();
  pv_d0(o, vb0 + v_prev, pa0, pa1, pa2, pa3); partialSM(pB0, pB1, m_reg, mnB, alB);
  RESC(alB);
  finishSM(pB0, pB1, alB, l_reg, pa0, pa1, pa2, pa3); SBAR();
  pv_d0(o, vb0 + v_cur, pa0, pa1, pa2, pa3);
  if (hi == 0) li_l[r32] = l_reg; asm volatile("s_waitcnt lgkmcnt(0)" ::: "memory");
  bf16_t* Ow = O + qrow0 * 1024 + h * 128 + r32;
#pragma unroll
  for (int r = 0; r < 16; ++r) { const int orow = crow(r, hi); const float rl = __builtin_amdgcn_rcpf(li_l[orow]);
#pragma unroll
    for (int d0 = 0; d0 < 4; ++d0) Ow[(size_t)orow * 1024 + d0 * 32] = (bf16_t)(cvtpk(o[d0][r] * rl, 0.f) & 0xffffu); }
  __syncthreads();
#undef TROW
#undef DMA
#undef RESC
#undef TOPBAR
#undef VNEXT
}
#undef SBAR
}

constexpr int S5_UL = 0, S5_UST = 1040, S5_HL = 75776, S5_HST = 528;
__device__ __forceinline__ float gelu_t(float x) { return x * sigm(1.5957691216057308f * x * (1.f + 0.044715f * x * x)); }
__device__ __forceinline__ void s5_unit(int g, int b, const bf16_t* __restrict__ Ub, const bf16_t* __restrict__ Kcomb, const bf16_t* __restrict__ Wtab, const bf16_t* __restrict__ Vtab,
                                        const float* a_re, const float* a_im, const float* log_dt, bf16_t* __restrict__ Z, LAS unsigned char* lds) {
    const int tid = opaque_tid(), lane = tid & 63, wave = __builtin_amdgcn_readfirstlane(tid >> 6), i = lane & 31, hi = lane >> 5;
    for (int idx = tid; idx < 4608; idx += 512) { const int tau = idx >> 1, half = idx & 1; const size_t row = tau < 256 ? (size_t)8192 + b * 256 + tau : (size_t)b * 2048 + tau - 256;
        *(LAS u32x4*)(lds + S5_UL + (tau >> 5) * S5_UST + (tau & 31) * 32 + half * 16) = *(const u32x4*)(Ub + row * 1024 + g * 16 + half * 8); }
    __syncthreads();
    {
        f32x16 a0 = {}, a1 = {}, a2 = {};
        const bf16_t* wt = Wtab + (size_t)g * 32 * 4096 + (wave * 32 + i) * 16 + hi * 8;
        const int c2 = (64 + i) < 72 ? 64 + i : 71;
        const LAS unsigned char* u0 = lds + S5_UL + i * S5_UST + hi * 16; const LAS unsigned char* u1 = lds + S5_UL + (32 + i) * S5_UST + hi * 16; const LAS unsigned char* u2 = lds + S5_UL + c2 * S5_UST + hi * 16;
#pragma unroll 16
        for (int s = 0; s < 32; ++s) { const bf16x8 af = *(const bf16x8*)(wt + s * 4096);
            a0 = __builtin_amdgcn_mfma_f32_32x32x16_bf16(af, *(const LAS bf16x8*)(u0 + s * 32), a0, 0, 0, 0);
            a1 = __builtin_amdgcn_mfma_f32_32x32x16_bf16(af, *(const LAS bf16x8*)(u1 + s * 32), a1, 0, 0, 0);
            a2 = __builtin_amdgcn_mfma_f32_32x32x16_bf16(af, *(const LAS bf16x8*)(u2 + s * 32), a2, 0, 0, 0); }
#pragma unroll
        for (int rr = 0; rr < 4; ++rr) { const int np = wave * 32 + 8 * rr + 4 * hi; u32x2 w;
            w.x = cvtpk(a0[4 * rr], a0[4 * rr + 1]); w.y = cvtpk(a0[4 * rr + 2], a0[4 * rr + 3]); *(LAS u32x2*)(lds + S5_HL + i * S5_HST + np * 2) = w;
            w.x = cvtpk(a1[4 * rr], a1[4 * rr + 1]); w.y = cvtpk(a1[4 * rr + 2], a1[4 * rr + 3]); *(LAS u32x2*)(lds + S5_HL + (32 + i) * S5_HST + np * 2) = w;
            w.x = cvtpk(a2[4 * rr], a2[4 * rr + 1]); w.y = cvtpk(a2[4 * rr + 2], a2[4 * rr + 3]); if (64 + i < 72) *(LAS u32x2*)(lds + S5_HL + (64 + i) * S5_HST + np * 2) = w; }
    }
    __syncthreads();
    if (wave < 2) { const int d = wave, n = lane, base = (d * 64 + g) * 64 + n; const Cx A32 = cpowk(a_re[base], a_im[base], __expf(log_dt[d * 64 + g]), 32.f);
        float hr = 0.f, him = 0.f; LAS unsigned char* hb = lds + S5_HL + (d * 128 + n) * 2;
#pragma unroll 4
        for (int st = 0; st < 72; ++st) { const int col = d == 0 ? st : (st < 8 ? 7 - st : 79 - st);
            LAS unsigned short* pr = (LAS unsigned short*)(hb + col * S5_HST); LAS unsigned short* pi = pr + 64;
            const float sre = bf2f(*pr), sim = bf2f(*pi);
            *pr = (unsigned short)(cvtpk(hr, 0.f) & 0xffffu); *pi = (unsigned short)(cvtpk(him, 0.f) & 0xffffu);
            const float nr = A32.re * hr - A32.im * him + sre, ni = A32.re * him + A32.im * hr + sim; hr = nr; him = ni; }
    }
    __syncthreads();
    f32x16 y00 = {}, y01 = {}, y10 = {}, y11 = {};
    {
        const int rb0 = 2 * wave;
        const bf16_t* kc = Kcomb + (size_t)g * 64 * 256 + (i >> 4) * 256 + (i & 15) * 16 + hi * 8;
        const LAS unsigned char* u0 = lds + S5_UL + (8 + i) * S5_UST + hi * 16; const LAS unsigned char* u1 = lds + S5_UL + (40 + i) * S5_UST + hi * 16;
#pragma unroll 16
        for (int s = 0; s < 32; ++s) { const bf16x8 f0 = *(const bf16x8*)(kc + (2 * rb0 - s + 32) * 256), f1 = *(const bf16x8*)(kc + (2 * rb0 + 2 - s + 32) * 256);
            const bf16x8 b0 = *(const LAS bf16x8*)(u0 + s * 32), b1 = *(const LAS bf16x8*)(u1 + s * 32);
            y00 = __builtin_amdgcn_mfma_f32_32x32x16_bf16(f0, b0, y00, 0, 0, 0); y01 = __builtin_amdgcn_mfma_f32_32x32x16_bf16(f0, b1, y01, 0, 0, 0);
            y10 = __builtin_amdgcn_mfma_f32_32x32x16_bf16(f1, b0, y10, 0, 0, 0); y11 = __builtin_amdgcn_mfma_f32_32x32x16_bf16(f1, b1, y11, 0, 0, 0); }
        const bf16_t* vt = Vtab + ((size_t)g * 16 + rb0) * 16 * 512 + i * 16 + hi * 8;
        const LAS unsigned char* h0 = lds + S5_HL + (8 + i) * S5_HST + hi * 16; const LAS unsigned char* h1 = lds + S5_HL + (40 + i) * S5_HST + hi * 16;
#pragma unroll 16
        for (int kk = 0; kk < 16; ++kk) { const bf16x8 f0 = *(const bf16x8*)(vt + kk * 512), f1 = *(const bf16x8*)(vt + 16 * 512 + kk * 512);
            const bf16x8 b0 = *(const LAS bf16x8*)(h0 + kk * 32), b1 = *(const LAS bf16x8*)(h1 + kk * 32);
            y00 = __builtin_amdgcn_mfma_f32_32x32x16_bf16(f0, b0, y00, 0, 0, 0); y01 = __builtin_amdgcn_mfma_f32_32x32x16_bf16(f0, b1, y01, 0, 0, 0);
            y10 = __builtin_amdgcn_mfma_f32_32x32x16_bf16(f1, b0, y10, 0, 0, 0); y11 = __builtin_amdgcn_mfma_f32_32x32x16_bf16(f1, b1, y11, 0, 0, 0); }
    }
    __syncthreads();
    {
        LAS unsigned char* zs = lds + S5_UL + wave * 8192;
#define S5_ST(ACC, RBI, NB) _Pragma("unroll") for (int rr = 0; rr < 4; ++rr) { const int tl = (RBI) * 2 + (rr >> 1), p0 = 8 * (rr & 1) + 4 * hi, ch = 32 * (NB) + i; u32x2 w; \
            w.x = cvtpk(gelu_t(ACC[4 * rr]), gelu_t(ACC[4 * rr + 1])); w.y = cvtpk(gelu_t(ACC[4 * rr + 2]), gelu_t(ACC[4 * rr + 3])); *(LAS u32x2*)(zs + (tl * 64 + ch) * 32 + p0 * 2) = w; }
        S5_ST(y00, 0, 0) S5_ST(y01, 0, 1) S5_ST(y10, 1, 0) S5_ST(y11, 1, 1)
#undef S5_ST
        LDS_WAIT();
#pragma unroll
        for (int j = 0; j < 8; ++j) { const int tok = j * 32 + (lane >> 1), half = lane & 1, tl = tok >> 6, ch = tok & 63; const u32x4 v = *(const LAS u32x4*)(zs + tok * 32 + half * 16);
            *(u32x4*)(Z + ((size_t)b * 2048 + ch * 32 + 4 * wave + tl) * 1024 + g * 16 + half * 8) = v; }
    }
    __syncthreads();
}

__global__ void __launch_bounds__(512) fwd_kernel(Params P) {
    extern __shared__ __attribute__((aligned(16))) unsigned char lds[];
    cg::grid_group grid = cg::this_grid();
    LAS unsigned char* L = (LAS unsigned char*)lds;
    const int G = gridDim.x, bx = blockIdx.x, vcu = (G % 8 == 0) ? (bx % 8) * (G / 8) + bx / 8 : bx;
    const int NGW = G * 8;
    unsigned char* ws = P.ws;
    float* CTL = (float*)(ws + WS_CTL); float* MOD = (float*)(ws + WS_MOD); float* BIAS2 = (float*)(ws + WS_BIAS2);
    bf16_t *Wt_in = (bf16_t*)(ws + WS_WIN), *Wt_glu = (bf16_t*)(ws + WS_WGLU), *Wt_uq = (bf16_t*)(ws + WS_WUQ), *Wt_ukv = (bf16_t*)(ws + WS_WUKV), *Wt_mo = (bf16_t*)(ws + WS_WMO),
           *Wt_out = (bf16_t*)(ws + WS_WOUT), *Wt_f1 = (bf16_t*)(ws + WS_WF1), *Wt_f2 = (bf16_t*)(ws + WS_WF2);
    bf16_t *GATES = (bf16_t*)(ws + WS_GATES), *XMOD = (bf16_t*)(ws + WS_XMOD), *Ub = (bf16_t*)(ws + WS_U), *CQKV = (bf16_t*)(ws + WS_CQKV), *KR = (bf16_t*)(ws + WS_KR),
           *Kcomb = (bf16_t*)(ws + WS_KCOMB), *Wtab = (bf16_t*)(ws + WS_WTAB), *Vtab = (bf16_t*)(ws + WS_VTAB), *Qb = (bf16_t*)(ws + WS_Q), *KN = (bf16_t*)(ws + WS_KN), *Vb = (bf16_t*)(ws + WS_V),
           *Zb = (bf16_t*)(ws + WS_Z), *Ob = (bf16_t*)(ws + WS_O), *S5P = (bf16_t*)(ws + WS_S5P), *MIX = (bf16_t*)(ws + WS_MIX), *X1S = (bf16_t*)(ws + WS_X1S), *ACT = (bf16_t*)(ws + WS_ACT);
    float* X1 = (float*)(ws + WS_X1);
    const float *a_re = P.in[I_ARE], *a_im = P.in[I_AIM], *log_dt = P.in[I_LOGDT], *b_re = P.in[I_BRE], *b_im = P.in[I_BIM], *c_re = P.in[I_CRE], *c_im = P.in[I_CIM];

#ifndef PROBE_REP
#define PROBE_REP 0
#endif
    const bool split = (G == 256);
    { volatile LAS unsigned* st_ = (volatile LAS unsigned*)(L + 147392); if (threadIdx.x == 0) { st_[0] = 0u; st_[1] = 0u; } __syncthreads(); }
    const XcdBarrier xbar = xcd_barrier_post((unsigned*)(CTL + 131072), (volatile LAS unsigned*)(L + 147392));
    if (PROBE_REP & 1024) { for (int q_ = 0; q_ < 8; ++q_) xcd_barrier(xbar); }
    for (int rep_ = 0; rep_ < ((PROBE_REP & 1) ? 2 : 1); ++rep_) {
    {
        const int tid = opaque_tid(), lane = tid & 63, wave = __builtin_amdgcn_readfirstlane(tid >> 6);
        if (!split || bx < 192) {
        LAS float* scl = (LAS float*)L;
        LAS f32x4* red = (LAS f32x4*)(L + 40960);
        for (int i = tid; i < 5 * 2048; i += 512) { const int v = i >> 11, k = i & 2047; const float cv = v < 4 ? P.in[I_C][v * 2048 + k] : P.in[I_CCTX][k]; scl[i] = cv * sigm(cv); }
        __syncthreads();
        for (int rp2_ = 0; rp2_ < ((PROBE_REP & 128) ? 2 : 1); ++rp2_)
        for (int item = bx; item < 192; item += G) {
            const int n0 = item * 64, c4 = lane & 15, rsub = lane >> 4;
            f32x4 a[5];
#pragma unroll
            for (int v = 0; v < 5; ++v) a[v] = (f32x4){0.f, 0.f, 0.f, 0.f};
            const float* wp = P.in[I_WMOD] + (size_t)(wave * 4 + rsub) * 12288 + n0 + c4 * 4;
#pragma unroll 8
            for (int it = 0; it < 64; ++it) { const int k = wave * 4 + rsub + 32 * it; const f32x4 w = __builtin_nontemporal_load((const f32x4*)(wp + (size_t)it * 32 * 12288));
#pragma unroll
                for (int v = 0; v < 5; ++v) a[v] += w * scl[v * 2048 + k]; }
#pragma unroll
            for (int v = 0; v < 5; ++v)
#pragma unroll
                for (int e = 0; e < 4; ++e) { float t = a[v][e]; t += __shfl_xor(t, 16); t += __shfl_xor(t, 32); a[v][e] = t; }
            if (lane < 16) {
#pragma unroll
                for (int v = 0; v < 5; ++v) red[(wave * 16 + c4) * 5 + v] = a[v]; }
            __syncthreads();
            if (tid < 80) { const int cc = tid & 15, v = tid >> 4; f32x4 s = *(const f32x4*)(P.in[I_BMOD] + n0 + cc * 4);
#pragma unroll
                for (int w = 0; w < 8; ++w) s += red[(w * 16 + cc) * 5 + v];
                *(f32x4*)(MOD + (size_t)v * 12288 + n0 + cc * 4) = s; }
            __syncthreads();
        }
        }
        if (!split || bx >= 192) {
        __syncthreads();
        LAS float* scr = (LAS float*)(L + wave * 16640);
        const int w0 = (split ? bx - 192 : bx) * 8 + wave, nw = (split ? 64 : G) * 8;
        auto dec_in = [&](int it) { TrItem t; t.nt = false; t.bias_sh = nullptr; t.bias_out = nullptr; const int kb = it / 93, n0 = (it % 93) * 64; t.W = P.in[I_WIN]; t.kscale = nullptr; t.WT = Wt_in; t.N = 5952; t.k0 = kb * 64; t.n0 = n0; t.ldt = 2048; t.drow0 = n0 < 1856 ? n0 : n0 + 192; t.rperm = (n0 == 1792); return t; };
        for (int rp4_ = 0; rp4_ < ((PROBE_REP & 512) ? 2 : 1); ++rp4_)
        TR_LOOP(dec_in, w0, 32 * 93, nw);
        for (int i = w0 * 64 + lane; i < 192 * 2048 / 8; i += nw * 64) *(u32x4*)(Wt_in + (size_t)1856 * 2048 + (size_t)i * 8) = (u32x4){0u, 0u, 0u, 0u};
        }
    }
    if (split) xcd_barrier(xbar); else grid.sync();
    }
    for (int rep_ = 0; rep_ < ((PROBE_REP & 32) ? 2 : 1); ++rep_) {
    {
        const int tid = opaque_tid(), lane = tid & 63, wave = __builtin_amdgcn_readfirstlane(tid >> 6);
        if (wave >= 4) {
        const int w0 = bx * 4 + (wave - 4), nw = G * 4; LAS float* scr = (LAS float*)(L + (wave - 4) * 8704);
        for (int it = w0; it < 64 * 63; it += nw) { const int g = it / 63, e = it % 63 + 1, dd = e - 32, p = lane >> 2, q0 = (lane & 3) * 4; float acc[4] = {0.f, 0.f, 0.f, 0.f};
            for (int d = 0; d < 2; ++d) { if ((dd > 0 && d == 1) || (dd < 0 && d == 0)) continue;
                { const int n = lane, base = (d * 64 + g) * 64 + n; const float lr = a_re[base], li = a_im[base], dt = __expf(log_dt[d * 64 + g]); const Cx co = s5_coef(lr, li, dt), pw = cpowk(lr, li, dt, (float)(dd < 0 ? -dd : dd));
                    scr[2 * n] = pw.re; scr[2 * n + 1] = pw.im;
#pragma unroll
                    for (int q = 0; q < 16; q += 4) { const f32x4 brv = *(const f32x4*)(b_re + (size_t)base * 16 + q), biv = *(const f32x4*)(b_im + (size_t)base * 16 + q);
#pragma unroll
                        for (int j = 0; j < 4; ++j) { Cx bq; bq.re = brv[j]; bq.im = biv[j]; const Cx bb = cmul(co, bq); scr[128 + n * 16 + q + j] = bb.re; scr[1152 + n * 16 + q + j] = bb.im; } } }
                LDS_WAIT();
                const float* cr = c_re + ((size_t)(d * 64 + g) * 16 + p) * 64; const float* cim = c_im + ((size_t)(d * 64 + g) * 16 + p) * 64;
#pragma unroll 4
                for (int n4 = 0; n4 < 64; n4 += 4) { const f32x4 crv = *(const f32x4*)(cr + n4), civ = *(const f32x4*)(cim + n4);
#pragma unroll
                    for (int e2 = 0; e2 < 4; ++e2) { const int n2 = n4 + e2; Cx c; c.re = crv[e2]; c.im = civ[e2]; Cx pn; pn.re = scr[2 * n2]; pn.im = scr[2 * n2 + 1]; const Cx ca = cmul(c, pn);
                        const f32x4 bre = *(const LAS f32x4*)(scr + 128 + n2 * 16 + q0), bim = *(const LAS f32x4*)(scr + 1152 + n2 * 16 + q0);
#pragma unroll
                        for (int j = 0; j < 4; ++j) acc[j] += ca.re * bre[j] - ca.im * bim[j]; } }
                LDS_WAIT();
            }
            if (dd == 0) { const float dsk = P.in[I_D][g * 16 + p];
#pragma unroll
                for (int j = 0; j < 4; ++j) if (q0 + j == p) acc[j] += dsk; }
            u32x2 w; w.x = cvtpk(acc[0], acc[1]); w.y = cvtpk(acc[2], acc[3]); *(u32x2*)(Kcomb + ((size_t)(g * 64 + e) * 16 + p) * 16 + q0) = w; }
            } else {
        const int gw = bx * 4 + wave, NGW4 = G * 4;
        for (int row = gw; row < 9216; row += 2 * NGW4) { const int row2 = row + NGW4; const bool has2 = row2 < 9216; const int rB = has2 ? row2 : row;
            const float* srcA = row < 8192 ? P.in[I_X] + (size_t)row * 2048 : P.in[I_CTX] + (size_t)(row - 8192) * 2048; const int vA = row < 8192 ? row >> 11 : 4;
            const float* srcB = rB < 8192 ? P.in[I_X] + (size_t)rB * 2048 : P.in[I_CTX] + (size_t)(rB - 8192) * 2048; const int vB = rB < 8192 ? rB >> 11 : 4;
            f32x4 xa[8], xb[8]; float sa = 0.f, sb = 0.f;
#pragma unroll
            for (int j = 0; j < 8; ++j) xa[j] = __builtin_nontemporal_load((const f32x4*)srcA + 64 * j + lane);
#pragma unroll
            for (int j = 0; j < 8; ++j) xb[j] = __builtin_nontemporal_load((const f32x4*)srcB + 64 * j + lane);
#pragma unroll
            for (int j = 0; j < 8; ++j) { sa += dot4(xa[j]); sb += dot4(xb[j]); }
            const float rsA = __builtin_amdgcn_rsqf(wave_sum(sa) * (1.f / 2048.f) + 1e-6f), rsB = __builtin_amdgcn_rsqf(wave_sum(sb) * (1.f / 2048.f) + 1e-6f);
            const float* modA = MOD + (size_t)vA * 12288; const float* modB = MOD + (size_t)vB * 12288;
#pragma unroll
            for (int j = 0; j < 8; ++j) { const int c = (64 * j + lane) * 4; const f32x4 n1 = *(const f32x4*)(P.in[I_NORM1] + c);
                const f32x4 oa = xa[j] * rsA * n1 * (*(const f32x4*)(modA + 2048 + c) + 1.f) + *(const f32x4*)(modA + c);
                u32x2 w; w.x = cvtpk(oa[0], oa[1]); w.y = cvtpk(oa[2], oa[3]); *(u32x2*)(XMOD + (size_t)row * 2048 + c) = w;
                if (has2) { const f32x4 ob = xb[j] * rsB * n1 * (*(const f32x4*)(modB + 2048 + c) + 1.f) + *(const f32x4*)(modB + c);
                    u32x2 w2; w2.x = cvtpk(ob[0], ob[1]); w2.y = cvtpk(ob[2], ob[3]); *(u32x2*)(XMOD + (size_t)row2 * 2048 + c) = w2; } } }
        }
    }
    xcd_barrier(xbar);
    }
    for (int rq_ = 0; rq_ < ((PROBE_REP & 8) ? 2 : 1); ++rq_)
    { pg8::Gemm g{XMOD, Wt_in, 9216, 6144, 2048, 2048, 2048}; pg8::P1Order S; S.init(G, bx);
      pg8::EpiIn E{Ub, CQKV, KR, GATES, CTL + SSQ_Q + rq_ * 65536, CTL + SSQ_KV + rq_ * 65536}; pg8::gemm_phase<pg8::EpiIn, pg8::P1Order, true, true>(L, g, S, E); }
    for (int rep_ = 0; rep_ < ((PROBE_REP & 64) ? 2 : 1); ++rep_)
    if (!split || bx >= 32) {
        const int tid = opaque_tid(), lane = tid & 63, wave = __builtin_amdgcn_readfirstlane(tid >> 6);
        const int w0 = (split ? bx - 32 : bx) * 8 + wave, nw = (split ? 224 : G) * 8;
        LAS float* scr = (LAS float*)(L + wave * 16640);
        constexpr int I_GLU = 16 * 64, I_UQ = 8 * 24, I_UKV = 4 * 32, I_MO = 16 * 32, I_OUT = 32 * 32, I_F1 = 32 * 176, I_F2 = 88 * 32;
        constexpr int NITEMS = I_GLU + I_UQ + I_UKV + I_MO + I_OUT + I_F1;
        auto dec_sh = [&](int it) { TrItem t; t.kscale = nullptr; t.rperm = false; t.nt = true; t.bias_sh = nullptr; t.bias_out = nullptr; int r = it;
            if (r < I_UQ) { const int kb = r / 24, n0 = (r % 24) * 64; t.W = P.in[I_WUQ]; t.kscale = P.in[I_QNORM]; t.WT = Wt_uq; t.N = 1536; t.k0 = kb * 64; t.n0 = n0; t.ldt = 512; t.drow0 = n0; t.rperm = (n0 % 192) == 128; return t; } r -= I_UQ;
            if (r < I_UKV) { const int kb = r / 32, n0 = (r % 32) * 64; t.W = P.in[I_WUKV]; t.kscale = P.in[I_KVNORM]; t.WT = Wt_ukv; t.N = 2048; t.k0 = kb * 64; t.n0 = n0; t.ldt = 256; t.drow0 = n0; return t; } r -= I_UKV;
            if (r < I_GLU) { const int kb = r / 64, n0 = (r % 64) * 64, j0 = n0 & 2047, hf = n0 >> 11; t.W = P.in[I_WGLU]; t.WT = Wt_glu; t.N = 4096; t.k0 = kb * 64; t.n0 = n0; t.ldt = 1024; t.drow0 = (j0 >> 7) * 256 + hf * 128 + (j0 & 127); return t; } r -= I_GLU;
            if (r < I_MO) { const int kb = r / 32, n0 = (r % 32) * 64; t.W = P.in[I_WMO]; t.WT = Wt_mo; t.N = 2048; t.k0 = kb * 64; t.n0 = n0; t.ldt = 1024; t.drow0 = n0; return t; } r -= I_MO;
            if (r < I_OUT) { const int kb = r / 32, n0 = (r % 32) * 64; t.W = P.in[I_WOUT]; t.WT = Wt_out; t.N = 2048; t.k0 = kb * 64; t.n0 = n0; t.ldt = 2048; t.drow0 = n0; return t; } r -= I_OUT;
            { const int kb = r / 176, n0 = (r % 176) * 64, j0 = n0 % 5632, hf = n0 / 5632; t.W = P.in[I_WF1]; t.WT = Wt_f1; t.N = 11264; t.k0 = kb * 64; t.n0 = n0; t.ldt = 2048; t.drow0 = (j0 >> 7) * 256 + hf * 128 + (j0 & 127); t.bias_sh = MOD + 3 * 2048; t.bias_out = BIAS2 + t.drow0; return t; } };
        TR_LOOP(dec_sh, w0, NITEMS, nw);
        for (int it = w0; it < 2048; it += nw) { const int g = it >> 5, s = it & 31, n = lane;
#pragma unroll
            for (int d = 0; d < 2; ++d) { const int base = (d * 64 + g) * 64 + n; const float lr = a_re[base], li = a_im[base], dt = __expf(log_dt[d * 64 + g]);
                const Cx pc = cmul(cpowk(lr, li, dt, d == 0 ? (float)(31 - s) : (float)s), s5_coef(lr, li, dt));
                const float* br = b_re + (size_t)base * 16; const float* bi = b_im + (size_t)base * 16; unsigned wre[8], wim[8];
#pragma unroll
                for (int q = 0; q < 16; q += 2) { Cx b0; b0.re = br[q]; b0.im = bi[q]; Cx b1; b1.re = br[q + 1]; b1.im = bi[q + 1]; const Cx v0 = cmul(pc, b0), v1 = cmul(pc, b1);
                    wre[q >> 1] = cvtpk(v0.re, v1.re); wim[q >> 1] = cvtpk(v0.im, v1.im); }
                bf16_t* dst = Wtab + ((size_t)(g * 32 + s) * 256 + d * 128 + n) * 16;
                *(u32x4*)dst = (u32x4){wre[0], wre[1], wre[2], wre[3]}; *(u32x4*)(dst + 8) = (u32x4){wre[4], wre[5], wre[6], wre[7]};
                *(u32x4*)(dst + 1024) = (u32x4){wim[0], wim[1], wim[2], wim[3]}; *(u32x4*)(dst + 1032) = (u32x4){wim[4], wim[5], wim[6], wim[7]}; } }
        for (int it = w0; it < 1024; it += nw) { const int g = it >> 4, kk = it & 15, i = lane & 31, hi = lane >> 5, th = i >> 4, p = i & 15, blk = kk >> 2, d = blk >> 1, isim = blk & 1, nb0 = (kk & 3) * 16 + 8 * hi;
            const float dt = __expf(log_dt[d * 64 + g]), e0 = d == 0 ? (float)(th + 1) : (float)(2 - th); const int base = (d * 64 + g) * 64 + nb0, ci = ((d * 64 + g) * 16 + p) * 64 + nb0;
            const f32x4 ar0 = *(const f32x4*)(a_re + base), ar1 = *(const f32x4*)(a_re + base + 4), ai0 = *(const f32x4*)(a_im + base), ai1 = *(const f32x4*)(a_im + base + 4);
            const f32x4 cr0 = *(const f32x4*)(c_re + ci), cr1 = *(const f32x4*)(c_re + ci + 4), ci0 = *(const f32x4*)(c_im + ci), ci1 = *(const f32x4*)(c_im + ci + 4);
            Cx pw[8], a2[8], cc[8];
#pragma unroll
            for (int j = 0; j < 8; ++j) { const float lr = j < 4 ? ar0[j & 3] : ar1[j & 3], li = j < 4 ? ai0[j & 3] : ai1[j & 3]; pw[j] = cpowk(lr, li, dt, e0); a2[j] = cpowk(lr, li, dt, 2.f); cc[j].re = j < 4 ? cr0[j & 3] : cr1[j & 3]; cc[j].im = j < 4 ? ci0[j & 3] : ci1[j & 3]; }
            for (int st = 0; st < 16; ++st) { const int rb = d == 0 ? st : 15 - st; float val[8];
#pragma unroll
                for (int j = 0; j < 8; ++j) { val[j] = isim ? -(cc[j].re * pw[j].im + cc[j].im * pw[j].re) : (cc[j].re * pw[j].re - cc[j].im * pw[j].im); pw[j] = cmul(pw[j], a2[j]); }
                *(u32x4*)(Vtab + ((((size_t)g * 16 + rb) * 16 + kk) * 32 + i) * 16 + 8 * hi) = (u32x4){cvtpk(val[0], val[1]), cvtpk(val[2], val[3]), cvtpk(val[4], val[5]), cvtpk(val[6], val[7])}; } }
    }
    xcd_barrier(xbar);
    for (int rep_ = 0; rep_ < ((PROBE_REP & 4) ? 2 : 1); ++rep_)
    for (int u = vcu; u < 256; u += G) s5_unit(u & 63, u >> 6, Ub, Kcomb, Wtab, Vtab, a_re, a_im, log_dt, Zb, L);
    for (int rq_ = 0; rq_ < ((PROBE_REP & 8192) ? 2 : 1); ++rq_)
    { pg8::Gemm g{CQKV, Wt_uq, 8192, 1536, 512, 768, 512}; pg8::StaticOrder S; S.init(8192, 1536, G, bx);
      pg8::EpiQ E{Qb, CTL + SSQ_Q}; pg8::gemm_phase<pg8::EpiQ, pg8::StaticOrder, true, true>(L, g, S, E); }
    __syncthreads();
    for (int rq_ = 0; rq_ < ((PROBE_REP & 8192) ? 2 : 1); ++rq_)
    { pg8::Gemm g{CQKV + 512, Wt_ukv, 9216, 2048, 256, 768, 256}; pg8::StaticOrder S; S.init(9216, 2048, G, (bx + 64) % G);
      pg8::EpiKV E{KN, Vb, CTL + SSQ_KV}; pg8::gemm_phase<pg8::EpiKV, pg8::StaticOrder, true, true>(L, g, S, E); }
    xcd_barrier(xbar);
    for (int rep_ = 0; rep_ < ((PROBE_REP & 2) ? 2 : 1); ++rep_)
    for (int u = vcu; u < 256; u += G) att::attn_unit(u >> 6, (u >> 3) & 7, u & 7, Qb, KN, KR, Vb, Ob, (char*)lds, L);
    for (int rq_ = 0; rq_ < ((PROBE_REP & 2048) ? 2 : 1); ++rq_)
    { pg8::Gemm g{Zb, Wt_glu, 8192, 4096, 1024, 1024, 1024}; pg8::StaticOrder S; S.init(8192, 4096, G, bx);
      pg8::EpiGlu E{S5P, GATES}; pg8::gemm_phase<pg8::EpiGlu, pg8::StaticOrder, true, true>(L, g, S, E); }
    xcd_barrier(xbar);
    for (int rq_ = 0; rq_ < ((PROBE_REP & 4096) ? 2 : 1); ++rq_)
    { pg8::Gemm g{Ob, Wt_mo, 8192, 2048, 1024, 1024, 1024}; pg8::StaticOrder S; S.init(8192, 2048, G, bx);
      pg8::EpiMix E{S5P, GATES, MIX}; pg8::gemm_phase<pg8::EpiMix, pg8::StaticOrder, true, true>(L, g, S, E); }
    xcd_barrier(xbar);
    for (int rq_ = 0; rq_ < ((PROBE_REP & 16384) ? 2 : 1); ++rq_)
    { pg8::Gemm g{MIX, Wt_out, 8192, 2048, 2048, 2048, 2048}; pg8::StaticOrder S; S.init(8192, 2048, G, bx);
      pg8::EpiOut E{P.in[I_X], MOD, P.in[I_NORM2], X1, CTL + SSQ_1 + rq_ * 65536, X1S}; pg8::gemm_phase<pg8::EpiOut, pg8::StaticOrder, true, true>(L, g, S, E); }
    xcd_barrier(xbar);
    for (int rep_ = 0; rep_ < ((PROBE_REP & 16) ? 2 : 1); ++rep_)
    { pg8::Gemm g{X1S, Wt_f1, 8192, 11264, 2048, 2048, 2048}; pg8::StaticOrder S; S.init(8192, 11264, G, bx);
      pg8::EpiFfn1 E{CTL + SSQ_1, BIAS2, ACT}; pg8::gemm_phase<pg8::EpiFfn1, pg8::StaticOrder, true, true>(L, g, S, E); }
    if (!split || bx >= 128) {
        const int tid = opaque_tid(), lane = tid & 63, wave = __builtin_amdgcn_readfirstlane(tid >> 6);
        const int w0 = (split ? bx - 128 : bx) * 8 + wave, nw = (split ? 128 : G) * 8;
        LAS float* scr = (LAS float*)(L + wave * 16640);
        auto dec_f2 = [&](int it) { TrItem t; t.kscale = nullptr; t.rperm = false; t.nt = false; t.bias_sh = nullptr; t.bias_out = nullptr; const int kb = it / 32, n0 = (it % 32) * 64; t.W = P.in[I_WF2]; t.WT = Wt_f2; t.N = 2048; t.k0 = kb * 64; t.n0 = n0; t.ldt = 5632; t.drow0 = n0; return t; };
        TR_LOOP(dec_f2, w0, 88 * 32, nw);
    }
    xcd_barrier(xbar);
    for (int rq_ = 0; rq_ < ((PROBE_REP & 32768) ? 2 : 1); ++rq_)
    { pg8::Gemm g{ACT, Wt_f2, 8192, 2048, 5632, 5632, 5632}; pg8::StaticOrder S; S.init(8192, 2048, G, bx);
      pg8::EpiFfn2 E{X1, MOD, P.in[I_NORMF], P.out, CTL + SSQ_2 + rq_ * 65536, (unsigned*)(CTL + 140000) + rq_ * 4096, split ? 1 : 0}; pg8::gemm_phase<pg8::EpiFfn2, pg8::StaticOrder, true, true>(L, g, S, E); }
    if (!split) {
    xcd_barrier(xbar);
    { const int tid = opaque_tid(), lane = tid & 63, wave = __builtin_amdgcn_readfirstlane(tid >> 6), gw = bx * 8 + wave;
    for (int row = gw; row < 8192; row += NGW) { const float rstd = __builtin_amdgcn_rsqf(CTL[SSQ_2 + row] * (1.f / 2048.f) + 1e-6f); f32x4* o = (f32x4*)(P.out + (size_t)row * 2048);
#pragma unroll
        for (int j = 0; j < 8; ++j) { const int c4 = 64 * j + lane; o[c4] = o[c4] * rstd * *(const f32x4*)(P.in[I_NORMF] + c4 * 4); } } }
    }
}

extern "C" void kernel_launch(void* const* d_in, const int* in_sizes, int n_in, void* d_out, int out_size, void* d_ws, size_t ws_size, hipStream_t stream) {
    static int grid = 0;
    if (grid == 0) {
        if (n_in != 27 || out_size != 8192 * 2048 || ws_size < WS_END) { fprintf(stderr, "kernel_launch: unexpected shapes (n_in %d out %d ws %zu)\n", n_in, out_size, ws_size); grid = -1; return; }
        int dev = 0, cus = 0, per_cu = 0;
        if (hipGetDevice(&dev) != hipSuccess || hipDeviceGetAttribute(&cus, hipDeviceAttributeMultiprocessorCount, dev) != hipSuccess) { grid = -1; return; }
        if (hipFuncSetAttribute((const void*)fwd_kernel, hipFuncAttributeMaxDynamicSharedMemorySize, LDS_BYTES) != hipSuccess) { fprintf(stderr, "kernel_launch: hipFuncSetAttribute failed\n"); grid = -1; return; }
        if (hipOccupancyMaxActiveBlocksPerMultiprocessor(&per_cu, (const void*)fwd_kernel, 512, LDS_BYTES) != hipSuccess || per_cu < 1) { fprintf(stderr, "kernel_launch: occupancy query gave %d\n", per_cu); per_cu = 1; }
        (void)hipGetLastError();
        grid = cus * per_cu;
    }
    if (grid < 0) return;
    (void)hipMemsetAsync((char*)d_ws + WS_CTL, 0, 2 * CTL_BYTES, stream);
    Params p{};
    for (int i = 0; i < 27; ++i) p.in[i] = (const float*)d_in[i];
    p.out = (float*)d_out; p.ws = (unsigned char*)d_ws;
    void* args[] = {&p};
    const hipError_t e = hipLaunchCooperativeKernel((const void*)fwd_kernel, dim3(grid), dim3(512), args, LDS_BYTES, stream);
    if (e != hipSuccess) fprintf(stderr, "kernel_launch: cooperative launch failed: %s (grid %d)\n", hipGetErrorString(e), grid);
}
```

```cpp
#include <hip/hip_runtime.h>
#include <hip/hip_cooperative_groups.h>
#include <cstdio>
#include <cstdint>
namespace cg = cooperative_groups;
namespace pg8 {
#define PG8_LAS __attribute__((address_space(3)))
typedef unsigned short bf16_t;
typedef short bf16x8 __attribute__((ext_vector_type(8)));
typedef float f32x4 __attribute__((ext_vector_type(4)));
typedef unsigned u32x4 __attribute__((ext_vector_type(4)));
constexpr int BM = 256, BK = 64, HALF = 128, HTB = HALF * BK * 2  , STAGE_BYTES = 8 * HTB, NXCD = 8, WGM = 8;

__host__ __device__ __forceinline__ int lds_byte(int r, int c) { const int st = (r >> 4) * 2 + (c >> 5), rr = r & 15, cc = c & 31, ob = rr * 64 + cc * 2; return st * 1024 + (ob ^ (((ob >> 9) & 1) << 5)); }
__host__ __device__ __forceinline__ void stage_rc(int b, int& R, int& C) { const int st = b / 1024, sb = b % 1024, swz = sb ^ (((sb >> 9) & 1) << 5); R = (st >> 1) * 16 + swz / 64; C = (st & 1) * 32 + (swz % 64) / 2; }
__host__ __device__ __forceinline__ int perm32(int rho) { const int n = rho >> 4, i = rho & 15; return 8 * (i >> 2) + 4 * n + (i & 3); }

struct Unit { int pm, pn; };
struct Gemm { const bf16_t* A; const bf16_t* Bt; int M, N, K, lda, ldb; };

struct StaticOrder {
    int nM, nN, nwg, G, c;
    __host__ __device__ void init(int M, int N, int G_, int c_) { nM = M / BM; nN = N / BM; nwg = nM * nN; G = G_; c = c_; }
    __host__ __device__ bool next(int i, Unit& u) const { return at((long)i * G + c, u); }
    __host__ __device__ bool at(long L, Unit& u) const {
        if (L >= nwg) return false;
        int wgid = (int)L; { const int q = nwg / NXCD, r = nwg % NXCD, xcd = wgid % NXCD, off = wgid / NXCD; wgid = (xcd < r ? xcd * (q + 1) : r * (q + 1) + (xcd - r) * q) + off; }
        const int nig = WGM * nN, gid = wgid / nig, fm = gid * WGM, gsz = (nM - fm) < WGM ? (nM - fm) : WGM;
        u.pm = fm + ((wgid % nig) % gsz); u.pn = (wgid % nig) / gsz; return true;
    }
    __device__ __forceinline__ void a_ready(const Unit&) const {}
    __device__ __forceinline__ void done(const Unit&) const {}
};


struct P1Order {
    StaticOrder so; int G, c;
    __host__ __device__ void init(int G_, int c_) { so.init(8192, 6144, G_, c_); G = G_; c = c_; }
    __host__ __device__ bool next(int i, Unit& u) const {
        const long L = (long)i * G + c; if (L < 768) return so.at(L, u);
        const int j = (int)(L - 768); if (j >= 32) return false; u.pm = 32 + (j & 3); u.pn = j >> 2; return true; }
    __device__ __forceinline__ void a_ready(const Unit&) const {}
    __device__ __forceinline__ void done(const Unit&) const {}
};

typedef float f32x2_t __attribute__((ext_vector_type(2))); typedef __bf16 bf16x2_t __attribute__((ext_vector_type(2)));
__device__ __forceinline__ unsigned cvtpk(float lo, float hi) { f32x2_t v = {lo, hi}; bf16x2_t b = __builtin_convertvector(v, bf16x2_t); return __builtin_bit_cast(unsigned, b); }
__device__ __forceinline__ u32x4 pack8(f32x4 a, f32x4 b) { u32x4 w; w.x = cvtpk(a[0], a[1]); w.y = cvtpk(a[2], a[3]); w.z = cvtpk(b[0], b[1]); w.w = cvtpk(b[2], b[3]); return w; }
__device__ __forceinline__ void unpack8(u32x4 w, f32x4& a, f32x4& b) {
    a[0] = __uint_as_float(w.x << 16); a[1] = __uint_as_float(w.x & 0xffff0000u); a[2] = __uint_as_float(w.y << 16); a[3] = __uint_as_float(w.y & 0xffff0000u);
    b[0] = __uint_as_float(w.z << 16); b[1] = __uint_as_float(w.z & 0xffff0000u); b[2] = __uint_as_float(w.w << 16); b[3] = __uint_as_float(w.w & 0xffff0000u); }
__device__ __forceinline__ float sigm(float x) { return __builtin_amdgcn_rcpf(1.f + __builtin_amdgcn_exp2f(-1.4426950408889634f * x)); }
__device__ __forceinline__ f32x4 sigm4(f32x4 v) { f32x4 o; o[0] = sigm(v[0]); o[1] = sigm(v[1]); o[2] = sigm(v[2]); o[3] = sigm(v[3]); return o; }
__device__ __forceinline__ float rowred(float s) { s += __shfl_xor(s, 16); s += __shfl_xor(s, 32); return s; }
__device__ __forceinline__ float dot4(f32x4 x) { return (x[0] * x[0] + x[1] * x[1]) + (x[2] * x[2] + x[3] * x[3]); }
__device__ __forceinline__ void rope4(f32x4& v0, f32x4& v1, int pos, int fq) {
#pragma unroll
    for (int i = 0; i < 4; ++i) { const float f = (float)(4 * fq + i); const float inv = __builtin_amdgcn_exp2f(-f * 0.8304820237218406f);
        const float rev = (float)pos * inv * 0.15915494309189535f; const float c = __builtin_amdgcn_cosf(rev), s = __builtin_amdgcn_sinf(rev);
        const float a = v0[i], b = v1[i]; v0[i] = a * c - b * s; v1[i] = b * c + a * s; }
}
#define LDNT4(p) __builtin_nontemporal_load((const f32x4*)(p))
#define LDNT16(p) __builtin_nontemporal_load((const u32x4*)(p))
#define EPI_ARGS f32x4 (&acc)[2][2][4][2], const Unit& u, int wr, int wc, int fr, int fq
#define EPI_ROWS _Pragma("unroll") for (int ai = 0; ai < 2; ++ai) _Pragma("unroll") for (int m = 0; m < 4; ++m)
constexpr float EPSN = 1e-6f;

struct EpiIn { static constexpr bool PERM = true, AFTER_DRAIN = false;
    bf16_t *U, *CQKV, *KR, *GATES; float *ssq_q, *ssq_kv;
    __device__ __forceinline__ void operator()(EPI_ARGS) const {
        const int pn = u.pn, row0 = u.pm * BM + wr * 64 + fr, cl = wc * 32 + 8 * fq;
        if (pn < 4) {
            EPI_ROWS { const int row = row0 + ai * HALF + m * 16;
#pragma unroll
                for (int bj = 0; bj < 2; ++bj) *(u32x4*)(U + (size_t)row * 1024 + pn * 256 + bj * HALF + cl) = pack8(acc[ai][bj][m][0], acc[ai][bj][m][1]); }
        } else if (pn < 7) {
            float* ssq = pn < 6 ? ssq_q : ssq_kv;
            EPI_ROWS { const int row = row0 + ai * HALF + m * 16; float s = 0.f;
#pragma unroll
                for (int bj = 0; bj < 2; ++bj) { s += dot4(acc[ai][bj][m][0]) + dot4(acc[ai][bj][m][1]);
                    *(u32x4*)(CQKV + (size_t)row * 768 + (pn - 4) * 256 + bj * HALF + cl) = pack8(acc[ai][bj][m][0], acc[ai][bj][m][1]); }
                s = rowred(s); if (fq == 0) atomicAdd(ssq + row, s); }
        } else if (pn == 7) {
            if (wc < 2) {
                EPI_ROWS { const int row = row0 + ai * HALF + m * 16; f32x4 v0 = acc[ai][0][m][0], v1 = acc[ai][0][m][1];
                    if (u.pm < 32) { const int l = row & 2047; rope4(v0, v1, wc == 0 ? (l >> 6) : (l & 63), fq); }
                    *(u32x4*)(KR + (size_t)row * 64 + cl) = pack8(v0, v1); }
            }
        } else if (u.pm < 32) {
            EPI_ROWS { const int row = row0 + ai * HALF + m * 16;
#pragma unroll
                for (int bj = 0; bj < 2; ++bj) *(u32x4*)(GATES + (size_t)row * 4096 + (pn - 8) * 256 + bj * HALF + cl) = pack8(sigm4(acc[ai][bj][m][0]), sigm4(acc[ai][bj][m][1])); }
        }
    }
};
struct EpiQ { static constexpr bool PERM = true, AFTER_DRAIN = false;
    bf16_t* Q; const float* ssq_q;
    __device__ __forceinline__ void operator()(EPI_ARGS) const {
        const int row0 = u.pm * BM + wr * 64 + fr;
        EPI_ROWS { const int row = row0 + ai * HALF + m * 16; const float rstd = __builtin_amdgcn_rsqf(ssq_q[row] * (1.f / 512.f) + EPSN); const int l = row & 2047;
#pragma unroll
            for (int bj = 0; bj < 2; ++bj) { const int colg = u.pn * BM + bj * HALF + wc * 32, off = colg % 192; f32x4 v0 = acc[ai][bj][m][0] * rstd, v1 = acc[ai][bj][m][1] * rstd;
                if (off >= 128) rope4(v0, v1, off < 160 ? (l >> 6) : (l & 63), fq);
                *(u32x4*)(Q + (size_t)row * 1536 + colg + 8 * fq) = pack8(v0, v1); } }
    }
};
struct EpiKV { static constexpr bool PERM = true, AFTER_DRAIN = false;
    bf16_t *KN, *V; const float* ssq_kv;
    __device__ __forceinline__ void operator()(EPI_ARGS) const {
        const int row0 = u.pm * BM + wr * 64 + fr, cl = wc * 32 + 8 * fq;
        EPI_ROWS { const int row = row0 + ai * HALF + m * 16; const float rstd = __builtin_amdgcn_rsqf(ssq_kv[row] * (1.f / 256.f) + EPSN);
            *(u32x4*)(KN + (size_t)row * 1024 + u.pn * 128 + cl) = pack8(acc[ai][0][m][0] * rstd, acc[ai][0][m][1] * rstd);
            *(u32x4*)(V + (size_t)row * 1024 + u.pn * 128 + cl) = pack8(acc[ai][1][m][0] * rstd, acc[ai][1][m][1] * rstd); }
    }
};
struct EpiGlu { static constexpr bool PERM = true, AFTER_DRAIN = false;
    bf16_t* S5P; const bf16_t* GATES;
    __device__ __forceinline__ void operator()(EPI_ARGS) const {
        const int row0 = u.pm * BM + wr * 64 + fr, c = u.pn * 128 + wc * 32 + 8 * fq;
        EPI_ROWS { const int row = row0 + ai * HALF + m * 16; f32x4 g0, g1; unpack8(LDNT16(GATES + (size_t)row * 4096 + c), g0, g1);
            *(u32x4*)(S5P + (size_t)row * 2048 + c) = pack8(g0 * acc[ai][0][m][0] * sigm4(acc[ai][1][m][0]), g1 * acc[ai][0][m][1] * sigm4(acc[ai][1][m][1])); }
    }
};
struct EpiMix { static constexpr bool PERM = true, AFTER_DRAIN = false;
    const bf16_t *S5P, *GATES; bf16_t* MIX;
    __device__ __forceinline__ void operator()(EPI_ARGS) const {
        const int row0 = u.pm * BM + wr * 64 + fr;
        EPI_ROWS { const int row = row0 + ai * HALF + m * 16;
#pragma unroll
            for (int bj = 0; bj < 2; ++bj) { const int c = u.pn * BM + bj * HALF + wc * 32 + 8 * fq; f32x4 g0, g1, s0, s1;
                unpack8(LDNT16(GATES + (size_t)row * 4096 + 2048 + c), g0, g1); unpack8(LDNT16(S5P + (size_t)row * 2048 + c), s0, s1);
                *(u32x4*)(MIX + (size_t)row * 2048 + c) = pack8(s0 + g0 * acc[ai][bj][m][0], s1 + g1 * acc[ai][bj][m][1]); } }
    }
};
struct EpiOut { static constexpr bool PERM = true, AFTER_DRAIN = false;
    const float *x, *MOD, *norm2; float *X1, *ssq; bf16_t* X1S;
    __device__ __forceinline__ void operator()(EPI_ARGS) const {
        const int row0 = u.pm * BM + wr * 64 + fr; const float* mod = MOD + (size_t)(u.pm >> 3) * 12288;
        EPI_ROWS { const int row = row0 + ai * HALF + m * 16; float s = 0.f;
#pragma unroll
            for (int bj = 0; bj < 2; ++bj) { const int c = u.pn * BM + bj * HALF + wc * 32 + 8 * fq; const size_t o = (size_t)row * 2048 + c;
                f32x4 x1v[2];
#pragma unroll
                for (int n = 0; n < 2; ++n) { const f32x4 g1 = *(const f32x4*)(mod + 2 * 2048 + c + 4 * n), xv = LDNT4(x + o + 4 * n);
                    x1v[n] = xv + g1 * acc[ai][bj][m][n]; *(f32x4*)(X1 + o + 4 * n) = x1v[n]; s += dot4(x1v[n]); }
                const f32x4 sa = *(const f32x4*)(norm2 + c) * (*(const f32x4*)(mod + 4 * 2048 + c) + 1.f), sb = *(const f32x4*)(norm2 + c + 4) * (*(const f32x4*)(mod + 4 * 2048 + c + 4) + 1.f);
                *(u32x4*)(X1S + o) = pack8(x1v[0] * sa, x1v[1] * sb); }
            s = rowred(s); if (fq == 0) atomicAdd(ssq + row, s); }
    }
};
struct EpiFfn1 { static constexpr bool PERM = true, AFTER_DRAIN = false;
    const float *ssq, *BIAS2; bf16_t* ACT;
    __device__ __forceinline__ void operator()(EPI_ARGS) const {
        const int row0 = u.pm * BM + wr * 64 + fr, cb = u.pn * BM + wc * 32 + 8 * fq; const float* bias = BIAS2 + (size_t)(u.pm >> 3) * 11264 + cb;
        const f32x4 ba0 = *(const f32x4*)(bias), ba1 = *(const f32x4*)(bias + 4), bb0 = *(const f32x4*)(bias + HALF), bb1 = *(const f32x4*)(bias + HALF + 4);
        EPI_ROWS { const int row = row0 + ai * HALF + m * 16; const float rstd = __builtin_amdgcn_rsqf(ssq[row] * (1.f / 2048.f) + EPSN);
            const f32x4 a0 = acc[ai][0][m][0] * rstd + ba0, a1 = acc[ai][0][m][1] * rstd + ba1, b0 = acc[ai][1][m][0] * rstd + bb0, b1 = acc[ai][1][m][1] * rstd + bb1;
            *(u32x4*)(ACT + (size_t)row * 5632 + u.pn * 128 + wc * 32 + 8 * fq) = pack8(a0 * sigm4(a0) * b0, a1 * sigm4(a1) * b1); }
    }
};
struct EpiFfn2 { static constexpr bool PERM = true, AFTER_DRAIN = false;
    const float *X1, *MOD, *normf; float *out, *ssq; unsigned* cnt; int fuse;
    __device__ __forceinline__ void operator()(EPI_ARGS) const {
        const int row0 = u.pm * BM + wr * 64 + fr; const float* mod = MOD + (size_t)(u.pm >> 3) * 12288 + 5 * 2048;
        EPI_ROWS { const int row = row0 + ai * HALF + m * 16; float s = 0.f;
#pragma unroll
            for (int bj = 0; bj < 2; ++bj) { const int c = u.pn * BM + bj * HALF + wc * 32 + 8 * fq; const size_t o = (size_t)row * 2048 + c;
#pragma unroll
                for (int n = 0; n < 2; ++n) { const f32x4 x2 = LDNT4(X1 + o + 4 * n) + *(const f32x4*)(mod + c + 4 * n) * acc[ai][bj][m][n]; acc[ai][bj][m][n] = x2; if (!fuse) *(f32x4*)(out + o + 4 * n) = x2; s += dot4(x2); } }
            s = rowred(s); if (fq == 0) atomicAdd(ssq + row, s); }
        if (!fuse) return;
        asm volatile("s_waitcnt vmcnt(0)" ::: "memory");
        unsigned* pc = cnt + 64 * u.pm;
        if ((threadIdx.x & 63) == 0) __hip_atomic_fetch_add(pc, 1u, __ATOMIC_RELAXED, __HIP_MEMORY_SCOPE_AGENT);
        if (threadIdx.x < 64) { unsigned sp = 0; while ((unsigned)__builtin_amdgcn_readfirstlane(__hip_atomic_load(pc, __ATOMIC_RELAXED, __HIP_MEMORY_SCOPE_AGENT)) < 64u) { __builtin_amdgcn_s_sleep(2); if (++sp > (1u << 20)) break; } }
        __builtin_amdgcn_fence(__ATOMIC_ACQUIRE, "agent");
        __syncthreads();
        EPI_ROWS { const int row = row0 + ai * HALF + m * 16; const float rstd = __builtin_amdgcn_rsqf(__hip_atomic_load(ssq + row, __ATOMIC_RELAXED, __HIP_MEMORY_SCOPE_AGENT) * (1.f / 2048.f) + EPSN);
#pragma unroll
            for (int bj = 0; bj < 2; ++bj) { const int c = u.pn * BM + bj * HALF + wc * 32 + 8 * fq; const size_t o = (size_t)row * 2048 + c;
#pragma unroll
                for (int n = 0; n < 2; ++n) *(f32x4*)(out + o + 4 * n) = acc[ai][bj][m][n] * rstd * *(const f32x4*)(normf + c + 4 * n); } }
    }
};

template <class Epi, class Sched, bool ALIGN_EPI = false, bool SP2 = false>
__device__ __forceinline__ void gemm_phase(PG8_LAS unsigned char* lds, const Gemm g, const Sched& S, const Epi& E) {
    int tid_o = threadIdx.x; asm volatile("" : "+v"(tid_o));
    const int tid = tid_o, wid = __builtin_amdgcn_readfirstlane(tid >> 6), lane = tid & 63, wr = wid >> 2, wc = wid & 3, fr = lane & 15, fq = lane >> 4;
    const int K = g.K, nt = K / BK;
    unsigned voffA[2], voffB[2];
#pragma unroll
    for (int i = 0; i < 2; ++i) { int R, C; stage_rc(tid * 16 + i * 8192, R, C); const int Rb = Epi::PERM ? ((R & ~31) + perm32(R & 31)) : R;
        voffA[i] = (unsigned)(R * g.lda + C) * 2u; voffB[i] = (unsigned)(Rb * g.ldb + C) * 2u; }
    const size_t kstep = (size_t)(BK * 2);
    const size_t hstepA = (size_t)HALF * g.lda * 2, hstepB = (size_t)HALF * g.ldb * 2;
    const size_t tstepA = 2 * hstepA, tstepB = 2 * hstepB;
    const unsigned ldsw = (unsigned)wid * 1024u;
    const int aoff = lds_byte(wr * 64 + fr, fq * 8), boff = lds_byte(wc * 32 + fr, fq * 8);
#define PG8_SA(b, h) (((b) * 2 + (h)) * HTB)
#define PG8_SB(b, h) ((4 + (b) * 2 + (h)) * HTB)
#define PG8_STAGE(bufoff, gbase, voff) do { _Pragma("unroll") for (int _i = 0; _i < 2; ++_i) \
        __builtin_amdgcn_global_load_lds((const unsigned*)((const char*)(gbase) + (voff)[_i]), (PG8_LAS unsigned*)(lds + (bufoff) + ldsw + _i * 8192), 16, 0, 0); } while (0)
#define PG8_LDA(dst, b, h) do { _Pragma("unroll") for (int m = 0; m < 4; ++m) _Pragma("unroll") for (int k = 0; k < 2; ++k) dst[m][k] = *(const PG8_LAS bf16x8*)(lds + PG8_SA(b, h) + aoff + m * 2048 + k * 1024); } while (0)
#define PG8_LDB(dst, b, h) do { _Pragma("unroll") for (int n = 0; n < 2; ++n) _Pragma("unroll") for (int k = 0; k < 2; ++k) dst[n][k] = *(const PG8_LAS bf16x8*)(lds + PG8_SB(b, h) + boff + n * 2048 + k * 1024); } while (0)
#define PG8_MMA(ai, bj, At, Bt) do { __builtin_amdgcn_s_setprio(1); _Pragma("unroll") for (int m = 0; m < 4; ++m) _Pragma("unroll") for (int n = 0; n < 2; ++n) _Pragma("unroll") for (int k = 0; k < 2; ++k) \
        acc[ai][bj][m][n] = __builtin_amdgcn_mfma_f32_16x16x32_bf16(Bt[n][k], At[m][k], acc[ai][bj][m][n], 0, 0, 0); __builtin_amdgcn_s_setprio(0); } while (0)
#define PG8_WAIT_V(n) asm volatile("s_waitcnt vmcnt(" #n ")" ::: "memory")
#define PG8_WAIT_L(n) asm volatile("s_waitcnt lgkmcnt(" #n ")" ::: "memory")
#define PG8_BAR __builtin_amdgcn_s_barrier()
#define PG8_SCHED __builtin_amdgcn_sched_barrier(0)
    Unit cur, nxt; int ui = 0;
    if (!S.next(0, cur)) return;
    f32x4 acc[2][2][4][2];
#pragma unroll
    for (int a = 0; a < 2; ++a)
#pragma unroll
        for (int b = 0; b < 2; ++b)
#pragma unroll
            for (int m = 0; m < 4; ++m)
#pragma unroll
                for (int n = 0; n < 2; ++n) acc[a][b][m][n] = (f32x4){0.f, 0.f, 0.f, 0.f};
    bf16x8 At[4][2], B0[2][2], B1[2][2];
    const char* cA = (const char*)g.A + (size_t)cur.pm * tstepA; const char* cB = (const char*)g.Bt + (size_t)cur.pn * tstepB;
    S.a_ready(cur);
    if constexpr (SP2) {
        PG8_STAGE(PG8_SB(0, 0), cB, voffB); PG8_STAGE(PG8_SB(0, 1), cB + hstepB, voffB); PG8_STAGE(PG8_SA(0, 0), cA, voffA); PG8_STAGE(PG8_SA(0, 1), cA + hstepA, voffA);
        if (wr == 1) PG8_BAR;
        PG8_WAIT_V(2); PG8_BAR;
        PG8_STAGE(PG8_SB(1, 0), cB + kstep, voffB); PG8_STAGE(PG8_SA(1, 0), cA + kstep, voffA); PG8_STAGE(PG8_SB(1, 1), cB + hstepB + kstep, voffB);
        PG8_WAIT_V(6); PG8_BAR;
    } else {
        PG8_STAGE(PG8_SB(0, 0), cB, voffB); PG8_STAGE(PG8_SA(0, 0), cA, voffA); PG8_STAGE(PG8_SB(0, 1), cB + hstepB, voffB); PG8_STAGE(PG8_SA(0, 1), cA + hstepA, voffA);
        if (wr == 1) PG8_BAR;
        PG8_WAIT_V(4); PG8_BAR;
        PG8_STAGE(PG8_SB(1, 0), cB + kstep, voffB); PG8_STAGE(PG8_SA(1, 0), cA + kstep, voffA); PG8_STAGE(PG8_SB(1, 1), cB + hstepB + kstep, voffB);
        PG8_WAIT_V(6); PG8_BAR;
    }
    for (;;) {
        const bool has_next = S.next(ui + 1, nxt);
        const char* nA = has_next ? (const char*)g.A + (size_t)nxt.pm * tstepA : cA; const char* nB = has_next ? (const char*)g.Bt + (size_t)nxt.pn * tstepB : cB;
        for (int t = 0; t < nt; t += 2) {
            const bool last = (t == nt - 2);
            const char* a1 = cA + (size_t)(t + 1) * kstep;
            const char* a2 = last ? nA : cA + (size_t)(t + 2) * kstep; const char* b2 = last ? nB : cB + (size_t)(t + 2) * kstep;
            const char* a3 = a2 + kstep; const char* b3 = b2 + kstep;
            if (last && has_next) S.a_ready(nxt);
            if constexpr (SP2) {
            PG8_LDB(B0, 0, 0); PG8_LDB(B1, 0, 1); PG8_SCHED; PG8_LDA(At, 0, 0); PG8_STAGE(PG8_SA(1, 1), a1 + hstepA, voffA);
            PG8_WAIT_V(8); PG8_WAIT_L(0); PG8_BAR; PG8_MMA(0, 0, At, B0); PG8_MMA(0, 1, At, B1); PG8_BAR; PG8_SCHED;
            PG8_LDA(At, 0, 1); PG8_STAGE(PG8_SB(0, 0), b2, voffB); PG8_STAGE(PG8_SB(0, 1), b2 + hstepB, voffB); PG8_STAGE(PG8_SA(0, 0), a2, voffA);
            PG8_WAIT_V(8); PG8_WAIT_L(0); PG8_BAR; PG8_MMA(1, 0, At, B0); PG8_MMA(1, 1, At, B1); PG8_BAR; PG8_SCHED;
            PG8_LDB(B0, 1, 0); PG8_LDB(B1, 1, 1); PG8_SCHED; PG8_LDA(At, 1, 0); PG8_STAGE(PG8_SA(0, 1), a2 + hstepA, voffA);
            PG8_WAIT_V(8); PG8_WAIT_L(0); PG8_BAR; PG8_MMA(0, 0, At, B0); PG8_MMA(0, 1, At, B1); PG8_BAR; PG8_SCHED;
            PG8_LDA(At, 1, 1); PG8_STAGE(PG8_SB(1, 0), b3, voffB); PG8_STAGE(PG8_SB(1, 1), b3 + hstepB, voffB); PG8_STAGE(PG8_SA(1, 0), a3, voffA);
            PG8_WAIT_V(8); PG8_WAIT_L(0); PG8_BAR; PG8_MMA(1, 0, At, B0); PG8_MMA(1, 1, At, B1); PG8_BAR; PG8_SCHED;
            } else {
            PG8_LDB(B0, 0, 0); PG8_SCHED; PG8_LDA(At, 0, 0); PG8_STAGE(PG8_SA(1, 1), a1 + hstepA, voffA);
            PG8_WAIT_L(8); PG8_BAR; PG8_WAIT_L(0); PG8_MMA(0, 0, At, B0); PG8_BAR; PG8_SCHED;
            PG8_LDB(B1, 0, 1); PG8_STAGE(PG8_SB(0, 0), b2, voffB);
            PG8_BAR; PG8_WAIT_L(0); PG8_MMA(0, 1, At, B1); PG8_BAR;
            PG8_LDA(At, 0, 1); PG8_STAGE(PG8_SA(0, 0), a2, voffA);
            PG8_BAR; PG8_WAIT_L(0); PG8_MMA(1, 0, At, B0); PG8_BAR; PG8_SCHED;
            PG8_STAGE(PG8_SB(0, 1), b2 + hstepB, voffB);
            PG8_WAIT_V(6); PG8_BAR; PG8_MMA(1, 1, At, B1); PG8_BAR;
            PG8_LDB(B0, 1, 0); PG8_SCHED; PG8_LDA(At, 1, 0); PG8_STAGE(PG8_SA(0, 1), a2 + hstepA, voffA);
            PG8_WAIT_L(8); PG8_BAR; PG8_WAIT_L(0); PG8_MMA(0, 0, At, B0); PG8_BAR; PG8_SCHED;
            PG8_LDB(B1, 1, 1); PG8_STAGE(PG8_SB(1, 0), b3, voffB);
            PG8_BAR; PG8_WAIT_L(0); PG8_MMA(0, 1, At, B1); PG8_BAR;
            PG8_LDA(At, 1, 1); PG8_STAGE(PG8_SA(1, 0), a3, voffA);
            PG8_BAR; PG8_WAIT_L(0); PG8_MMA(1, 0, At, B0); PG8_BAR; PG8_SCHED;
            PG8_STAGE(PG8_SB(1, 1), b3 + hstepB, voffB);
            PG8_WAIT_V(6); PG8_BAR; PG8_MMA(1, 1, At, B1); PG8_BAR;
            }
        }
        if constexpr (ALIGN_EPI) { if (wr == 0) PG8_BAR; }
        if constexpr (!Epi::AFTER_DRAIN) { E(acc, cur, wr, wc, fr, fq); S.done(cur); }
        if (!has_next) break;
#pragma unroll
        for (int a = 0; a < 2; ++a)
#pragma unroll
            for (int b = 0; b < 2; ++b)
#pragma unroll
                for (int m = 0; m < 4; ++m)
#pragma unroll
                    for (int n = 0; n < 2; ++n) acc[a][b][m][n] = (f32x4){0.f, 0.f, 0.f, 0.f};
        cur = nxt; cA = nA; cB = nB; ++ui;
        if constexpr (ALIGN_EPI) { if (wr == 1) PG8_BAR; }
    }
    PG8_WAIT_V(0);
    if constexpr (!ALIGN_EPI) { if (wr == 0) PG8_BAR; }
    PG8_BAR;
    if constexpr (Epi::AFTER_DRAIN) { E.fused(acc, cur, wr, wc, fr, fq, lds, wid, lane); S.done(cur); }
#undef PG8_SA
#undef PG8_SB
#undef PG8_STAGE
#undef PG8_LDA
#undef PG8_LDB
#undef PG8_MMA
#undef PG8_WAIT_V
#undef PG8_WAIT_L
#undef PG8_BAR
#undef PG8_SCHED
}
}


#define LAS __attribute__((address_space(3)))
typedef unsigned short bf16_t;
typedef short bf16x8 __attribute__((ext_vector_type(8)));
typedef short s16x4 __attribute__((ext_vector_type(4)));
typedef float f32x4 __attribute__((ext_vector_type(4)));
typedef float f32x16 __attribute__((ext_vector_type(16)));
typedef unsigned u32x4 __attribute__((ext_vector_type(4)));
typedef unsigned u32x2 __attribute__((ext_vector_type(2)));
using pg8::cvtpk; using pg8::pack8; using pg8::unpack8; using pg8::sigm; using pg8::dot4;
#define LDS_WAIT() asm volatile("s_waitcnt lgkmcnt(0)" ::: "memory")
__device__ __forceinline__ int opaque_tid() { int t = threadIdx.x; asm volatile("" : "+v"(t)); return t; }

constexpr size_t MiB = 1u << 20;
constexpr size_t WS_CTL = 0, CTL_BYTES = 1 * MiB;
constexpr size_t WS_MOD = 1 * MiB, WS_BIAS2 = 1 * MiB + 512 * 1024;
constexpr size_t WS_WIN = 2 * MiB, WS_WGLU = 26 * MiB, WS_WUQ = 34 * MiB, WS_WUKV = 36 * MiB, WS_WMO = 38 * MiB, WS_WOUT = 42 * MiB, WS_WF1 = 50 * MiB, WS_WF2 = 94 * MiB;
constexpr size_t WS_GATES = 116 * MiB, WS_XMOD = 180 * MiB, WS_U = 216 * MiB, WS_CQKV = 234 * MiB, WS_KR = 248 * MiB, WS_KCOMB = 250 * MiB, WS_WTAB = 252 * MiB, WS_VTAB = 268 * MiB;
constexpr size_t WS_Q = 284 * MiB, WS_KN = 308 * MiB, WS_V = 326 * MiB, WS_Z = 344 * MiB;
constexpr size_t WS_O = 180 * MiB, WS_S5P = 216 * MiB, WS_MIX = 252 * MiB, WS_X1 = 284 * MiB, WS_X1S = 204 * MiB, WS_ACT = 116 * MiB;
constexpr size_t WS_END = 360 * MiB;
constexpr int SSQ_Q = 0, SSQ_KV = 16384, SSQ_1 = 32768, SSQ_2 = 49152;
constexpr int LDS_BYTES = 147456;

struct Params { const float* in[27]; float* out; unsigned char* ws; };
enum { I_X = 0, I_C, I_CTX, I_CCTX, I_WMOD, I_BMOD, I_NORM1, I_NORM2, I_WIN, I_ARE, I_AIM, I_LOGDT, I_BRE, I_BIM, I_CRE, I_CIM, I_D, I_WGLU, I_QNORM, I_KVNORM, I_WUQ, I_WUKV, I_WMO, I_WOUT, I_WF1, I_WF2, I_NORMF };

__device__ __forceinline__ float wave_sum(float v) {
#pragma unroll
    for (int o = 1; o < 64; o <<= 1) v += __shfl_xor(v, o);
    return v;
}
__device__ __forceinline__ float dot4m(f32x4 a, f32x4 b) { return (a[0] * b[0] + a[1] * b[1]) + (a[2] * b[2] + a[3] * b[3]); }
__device__ __forceinline__ float bf2f(unsigned short u) { return __uint_as_float((unsigned)u << 16); }

struct TrItem { const float* W; const float* kscale; bf16_t* WT; const float* bias_sh; float* bias_out; int N, k0, n0, ldt, drow0; bool rperm, nt; };
__device__ __forceinline__ void tr_load(f32x4 (&v)[16], const TrItem& t, int lane) {
    const int r4 = lane >> 4, c4 = lane & 15;
#pragma unroll
    for (int i = 0; i < 16; ++i) v[i] = __builtin_nontemporal_load((const f32x4*)(t.W + (size_t)(t.k0 + r4 + 4 * i) * t.N + t.n0 + 4 * c4));
}
__device__ __forceinline__ void tr_finish(const f32x4 (&v)[16], const TrItem& t, LAS float* scr, int lane) {
    const int r4 = lane >> 4, c4 = lane & 15;
#pragma unroll
    for (int i = 0; i < 16; ++i) { const int kk = r4 + 4 * i; f32x4 w = v[i]; if (t.kscale) w = w * t.kscale[t.k0 + kk]; LAS float* d = scr + kk * 65 + 4 * c4; d[0] = w[0]; d[1] = w[1]; d[2] = w[2]; d[3] = w[3]; }
    LDS_WAIT();
    if (t.bias_out) {
        float a0 = 0.f, a1 = 0.f, a2 = 0.f, a3 = 0.f; const float* sh = t.bias_sh + t.k0;
#pragma unroll 1
        for (int k4 = 0; k4 < 64; k4 += 4) { const f32x4 s0 = *(const f32x4*)(sh + k4), s1 = *(const f32x4*)(sh + 12288 + k4), s2 = *(const f32x4*)(sh + 2 * 12288 + k4), s3 = *(const f32x4*)(sh + 3 * 12288 + k4);
#pragma unroll
            for (int e = 0; e < 4; ++e) { const float w = scr[(k4 + e) * 65 + lane]; a0 += w * s0[e]; a1 += w * s1[e]; a2 += w * s2[e]; a3 += w * s3[e]; } }
        atomicAdd(t.bias_out + lane, a0); atomicAdd(t.bias_out + 11264 + lane, a1); atomicAdd(t.bias_out + 2 * 11264 + lane, a2); atomicAdd(t.bias_out + 3 * 11264 + lane, a3);
    }
    const int c = lane & 7;
#pragma unroll
    for (int j = 0; j < 8; ++j) { const int n = (lane >> 3) + 8 * j; const int sn = t.rperm ? ((n & 32) | (((n >> 2) & 1) * 16 + ((n >> 3) & 3) * 4 + (n & 3))) : n;
        const LAS float* s = scr + (8 * c) * 65 + sn;
        u32x4 o; o.x = cvtpk(s[0], s[65]); o.y = cvtpk(s[130], s[195]); o.z = cvtpk(s[260], s[325]); o.w = cvtpk(s[390], s[455]);
        u32x4* dp = (u32x4*)(t.WT + (size_t)(t.drow0 + n) * t.ldt + t.k0 + 8 * c); if (t.nt) __builtin_nontemporal_store(o, dp); else *dp = o; }
    LDS_WAIT();
}
#define TR_LOOP(DECODE, FIRST, COUNT, STRIDE) do { int it_ = (FIRST); f32x4 va_[16], vb_[16]; TrItem ta_, tb_; \
    if (it_ < (COUNT)) { ta_ = DECODE(it_); tr_load(va_, ta_, lane); } \
    while (it_ < (COUNT)) { int nx_ = it_ + (STRIDE); if (nx_ < (COUNT)) { tb_ = DECODE(nx_); tr_load(vb_, tb_, lane); } tr_finish(va_, ta_, scr, lane); it_ = nx_; if (it_ >= (COUNT)) break; \
        nx_ = it_ + (STRIDE); if (nx_ < (COUNT)) { ta_ = DECODE(nx_); tr_load(va_, ta_, lane); } tr_finish(vb_, tb_, scr, lane); it_ = nx_; } } while (0)
struct Cx { float re, im; };
__device__ __forceinline__ Cx cmul(Cx a, Cx b) { Cx r; r.re = a.re * b.re - a.im * b.im; r.im = a.re * b.im + a.im * b.re; return r; }
__device__ __forceinline__ Cx cpowk(float lr, float li, float dt, float k) {
    const float mag = __builtin_amdgcn_exp2f(k * lr * dt * 1.4426950408889634f);
    float rev = k * (li * dt * 0.15915494309189535f); rev -= floorf(rev);
    Cx r; r.re = mag * __builtin_amdgcn_cosf(rev); r.im = mag * __builtin_amdgcn_sinf(rev); return r; }
__device__ __forceinline__ Cx s5_coef(float lr, float li, float dt) {
    const Cx ab = cpowk(lr, li, dt, 1.f); const float den = lr * lr + li * li, nr = ab.re - 1.f, ni = ab.im;
    Cx r; r.re = (nr * lr + ni * li) / den; r.im = (ni * lr - nr * li) / den; return r; }

#define XB_TMO      128
#define XB_XCNT(j)  (256  + 64 * (j))
#define XB_XSUB(j)  (1280 + 64 * (j))
#define XB_XGEN(j)  (2304 + 64 * (j))
#define XB_TOP      3328
#define XB_TOPGEN   3392
#define XCD_BAR_WORDS 3456
#define XB_SPIN_CAP (1u << 18)

__device__ __forceinline__ unsigned xb_ld(unsigned* p)              { return __hip_atomic_load(p, __ATOMIC_RELAXED, __HIP_MEMORY_SCOPE_AGENT); }
__device__ __forceinline__ unsigned xb_add(unsigned* p, unsigned v) { return __hip_atomic_fetch_add(p, v, __ATOMIC_RELAXED, __HIP_MEMORY_SCOPE_AGENT); }
__device__ __forceinline__ unsigned xb_xcc_id() { return (unsigned)__builtin_amdgcn_s_getreg((3 << 11) | 20) & 0xFu; }
#define XB_SPIN(cond, bar) do { unsigned _sp = 0; while (cond) { __builtin_amdgcn_s_sleep(1); \
    if ((++_sp & 255u) == 0u) { if (xb_ld(&(bar)[XB_TMO])) break; if (_sp > XB_SPIN_CAP) { atomicAdd(&(bar)[XB_TMO], 1u); break; } } } } while (0)

struct XcdBarrier {
    unsigned* bar; unsigned x;
    volatile LAS unsigned* st;
};

__device__ __forceinline__ XcdBarrier xcd_barrier_post(unsigned* bar, volatile LAS unsigned* st) {
    XcdBarrier b; b.bar = bar; b.x = xb_xcc_id(); b.st = st;
    if (threadIdx.x == 0) (void)xb_add(&bar[XB_XCNT(b.x)], 1u);
    return b;
}
__device__ __forceinline__ void xcd_barrier_complete(unsigned* bar, unsigned x, unsigned& nloc, unsigned& nx) {
    const unsigned G = gridDim.x * gridDim.y * gridDim.z;
    unsigned sum, cnt, mine, sp = 0u;
    for (;;) {
        sum = 0u; cnt = 0u; mine = 0u;
#pragma unroll
        for (unsigned j = 0; j < 16; ++j) { const unsigned c = xb_ld(&bar[XB_XCNT(j)]); sum += c; cnt += (c > 0u) ? 1u : 0u; mine = (j == x) ? c : mine; }
        if (sum == G) break;
        __builtin_amdgcn_s_sleep(1);
        if ((++sp & 255u) == 0u) { if (xb_ld(&bar[XB_TMO])) break; if (sp > XB_SPIN_CAP) { atomicAdd(&bar[XB_TMO], 1u); break; } }
    }
    nloc = mine > 0u ? mine : 1u; nx = cnt > 0u ? cnt : 1u;
}

__device__ __forceinline__ void xcd_barrier(const XcdBarrier& b) {
    asm volatile("s_waitcnt vmcnt(0)" ::: "memory");
    __syncthreads();
    if (threadIdx.x == 0) {
        unsigned* bar = b.bar;
        __builtin_amdgcn_s_waitcnt(0);
        unsigned nloc = b.st[0], nx = b.st[1];
        if (nloc == 0u) { xcd_barrier_complete(bar, b.x, nloc, nx); b.st[0] = nloc; b.st[1] = nx; }
        const unsigned old = xb_add(&bar[XB_XSUB(b.x)], 1u);
        const unsigned gen = old / nloc;
        if (old + 1u == (gen + 1u) * nloc) {
            __builtin_amdgcn_fence(__ATOMIC_RELEASE, "agent");
            asm volatile("s_waitcnt vmcnt(0)" ::: "memory");
            const unsigned og = xb_add(&bar[XB_TOP], 1u);
            const unsigned tg = og / nx;
            if (og + 1u == (tg + 1u) * nx) xb_add(&bar[XB_TOPGEN], 1u);
            else XB_SPIN(xb_ld(&bar[XB_TOPGEN]) == tg, bar);
            __builtin_amdgcn_fence(__ATOMIC_ACQUIRE, "agent");
            xb_add(&bar[XB_XGEN(b.x)], 1u);
            asm volatile("s_waitcnt vmcnt(0)" ::: "memory");
        } else {
            XB_SPIN(xb_ld(&bar[XB_XGEN(b.x)]) == gen, bar);
            __builtin_amdgcn_fence(__ATOMIC_ACQUIRE, "agent");
            asm volatile("s_waitcnt vmcnt(0)" ::: "memory");
        }
    }
    __syncthreads();
}


namespace att {
constexpr float SCALE = 0.07216878364870323f;
constexpr float THR = 8.f;
#define KSWZ(row, colB) ((row) * 256 + ((colB) ^ (((row) & 7) << 4)))
#define RSWZ(row, colB) ((row) * 128 + ((colB) ^ ((((row) >> 1) & 7) << 4)))
#define SBAR() __builtin_amdgcn_sched_barrier(0)
__device__ __forceinline__ int crow(int r, int hi) { return (r & 3) + 8 * (r >> 2) + 4 * hi; }
__device__ __forceinline__ void partialSM(f32x16& p0, f32x16& p1, float& m_reg, float& mn, float& alpha) {
  constexpr float C = SCALE * 1.4426950408889634f;
  float pmax = p0[0];
#pragma unroll
  for (int r = 1; r < 16; ++r) pmax = fmaxf(pmax, p0[r]);
#pragma unroll
  for (int r = 0; r < 16; ++r) pmax = fmaxf(pmax, p1[r]);
  { auto rr = __builtin_amdgcn_permlane32_swap(__float_as_uint(pmax), __float_as_uint(pmax), false, false);
    pmax = fmaxf(__uint_as_float(rr[0]), __uint_as_float(rr[1])); }
  if (__builtin_expect(__all(pmax - m_reg <= THR / SCALE), 1)) { mn = m_reg; alpha = 1.f; }
  else { mn = fmaxf(m_reg, pmax); alpha = __builtin_amdgcn_exp2f((m_reg - mn) * C); m_reg = mn; }
  const float mnC = -mn * C;
#pragma unroll
  for (int r = 0; r < 16; ++r) p0[r] = fmaf(p0[r], C, mnC);
#pragma unroll
  for (int r = 0; r < 16; ++r) p1[r] = fmaf(p1[r], C, mnC);
#pragma unroll
  for (int r = 0; r < 16; ++r) p0[r] = __builtin_amdgcn_exp2f(p0[r]);
}
__device__ __forceinline__ void finishSM(f32x16& p0, f32x16& p1, float alpha, float& l_reg, bf16x8& pa0, bf16x8& pa1, bf16x8& pa2, bf16x8& pa3) {
#pragma unroll
  for (int r = 0; r < 16; ++r) p1[r] = __builtin_amdgcn_exp2f(p1[r]);
  float ps = 0;
#pragma unroll
  for (int r = 0; r < 16; ++r) ps += p0[r];
#pragma unroll
  for (int r = 0; r < 16; ++r) ps += p1[r];
  { auto rr = __builtin_amdgcn_permlane32_swap(__float_as_uint(ps), __float_as_uint(ps), false, false);
    ps = __uint_as_float(rr[0]) + __uint_as_float(rr[1]); }
  l_reg = l_reg * alpha + ps;
#define PK4(P, BASE, OUT) do { unsigned a0 = cvtpk(P[BASE + 0], P[BASE + 1]), a1 = cvtpk(P[BASE + 2], P[BASE + 3]);   \
    unsigned b0 = cvtpk(P[BASE + 4], P[BASE + 5]), b1 = cvtpk(P[BASE + 6], P[BASE + 7]);                              \
    auto r0 = __builtin_amdgcn_permlane32_swap(a0, b0, false, false); auto r1 = __builtin_amdgcn_permlane32_swap(a1, b1, false, false); \
    u32x4 w = {r0[0], r1[0], r0[1], r1[1]}; OUT = __builtin_bit_cast(bf16x8, w); } while (0)
  PK4(p0, 0, pa0); PK4(p0, 8, pa1); PK4(p1, 0, pa2); PK4(p1, 8, pa3);
#undef PK4
}
__device__ __forceinline__ void qkt(f32x16& p0, f32x16& p1, const char* Ks, const char* Rs, const bf16x8* qr, int r32, int hi) {
  p0 = f32x16{}; p1 = f32x16{};
#pragma unroll
  for (int d0 = 0; d0 < 8; ++d0) { const int cb = (d0 * 16 + hi * 8) * 2;
    const bf16x8 b0 = *reinterpret_cast<const bf16x8*>(Ks + KSWZ(r32, cb));
    const bf16x8 b1 = *reinterpret_cast<const bf16x8*>(Ks + KSWZ(32 + r32, cb));
    p0 = __builtin_amdgcn_mfma_f32_32x32x16_bf16(b0, qr[d0], p0, 0, 0, 0);
    p1 = __builtin_amdgcn_mfma_f32_32x32x16_bf16(b1, qr[d0], p1, 0, 0, 0); }
#pragma unroll
  for (int d0 = 0; d0 < 4; ++d0) { const int cb = (d0 * 16 + hi * 8) * 2;
    const bf16x8 b0 = *reinterpret_cast<const bf16x8*>(Rs + RSWZ(r32, cb));
    const bf16x8 b1 = *reinterpret_cast<const bf16x8*>(Rs + RSWZ(32 + r32, cb));
    p0 = __builtin_amdgcn_mfma_f32_32x32x16_bf16(b0, qr[8 + d0], p0, 0, 0, 0);
    p1 = __builtin_amdgcn_mfma_f32_32x32x16_bf16(b1, qr[8 + d0], p1, 0, 0, 0); }
}
__device__ __forceinline__ int v_st(int k, int c) { const int kk = (k & ~0xC) | ((k & 4) << 1) | ((k & 8) >> 1); return ((kk >> 3) * 4 + (c >> 5)) * 512 + ((kk & 7) * 32 + (c & 31)) * 2; }
__device__ __forceinline__ int v_rd_base(int lane) { return ((lane & 3) << 3) | (((lane >> 2) & 3) << 6) | (((lane >> 4) & 1) << 5) | (((lane >> 5) & 1) << 8); }
constexpr int v_rd_off(int d0, int ks, int half) { return d0 * 512 + ks * 4096 + half * 2048; }
template <int OFF> __device__ __forceinline__ s16x4 tr_read(int vb) {
  s16x4 r; asm volatile("ds_read_b64_tr_b16 %0, %1 offset:%2" : "=&v"(r) : "v"(vb), "i"(OFF) : "memory"); return r;
}
template <int D0> __device__ __forceinline__ void pv_one(f32x16& od, int vb, bf16x8 pa0, bf16x8 pa1, bf16x8 pa2, bf16x8 pa3) {
  const s16x4 l0 = tr_read<v_rd_off(D0, 0, 0)>(vb), h0 = tr_read<v_rd_off(D0, 0, 1)>(vb), l1 = tr_read<v_rd_off(D0, 1, 0)>(vb), h1 = tr_read<v_rd_off(D0, 1, 1)>(vb);
  const s16x4 l2 = tr_read<v_rd_off(D0, 2, 0)>(vb), h2 = tr_read<v_rd_off(D0, 2, 1)>(vb), l3 = tr_read<v_rd_off(D0, 3, 0)>(vb), h3 = tr_read<v_rd_off(D0, 3, 1)>(vb);
  asm volatile("s_waitcnt lgkmcnt(0)" ::: "memory"); SBAR();
#define PK(L, H) (bf16x8){L[0], L[1], L[2], L[3], H[0], H[1], H[2], H[3]}
  od = __builtin_amdgcn_mfma_f32_32x32x16_bf16(pa0, PK(l0, h0), od, 0, 0, 0);
  od = __builtin_amdgcn_mfma_f32_32x32x16_bf16(pa1, PK(l1, h1), od, 0, 0, 0);
  od = __builtin_amdgcn_mfma_f32_32x32x16_bf16(pa2, PK(l2, h2), od, 0, 0, 0);
  od = __builtin_amdgcn_mfma_f32_32x32x16_bf16(pa3, PK(l3, h3), od, 0, 0, 0);
#undef PK
}
__device__ __forceinline__ void pv_d0(f32x16* o, int vb, bf16x8 pa0, bf16x8 pa1, bf16x8 pa2, bf16x8 pa3) {
  pv_one<0>(o[0], vb, pa0, pa1, pa2, pa3); pv_one<1>(o[1], vb, pa0, pa1, pa2, pa3); pv_one<2>(o[2], vb, pa0, pa1, pa2, pa3); pv_one<3>(o[3], vb, pa0, pa1, pa2, pa3);
}
#define GLDS16(gp, lp) __builtin_amdgcn_global_load_lds((const unsigned*)(gp), (LAS unsigned*)(lp), 16, 0, 0)
__device__ __forceinline__ void attn_unit(int b, int h, int qb, const bf16_t* __restrict__ Q, const bf16_t* __restrict__ KN, const bf16_t* __restrict__ KR, const bf16_t* __restrict__ V, bf16_t* __restrict__ O, char* lds, LAS unsigned char* L3) {
  const int tid = opaque_tid(), wid = __builtin_amdgcn_readfirstlane(tid >> 6), lane = tid & 63, r32 = lane & 31, hi = lane >> 5;
  char* K_lds = lds + 49152; char* R_lds = lds + 81920;
  float* ws = (float*)(lds + 98304) + wid * 64; float* li_l = ws; float* al_l = ws + 32;
  float m_reg = -1e30f, l_reg = 0; f32x16 o[4] = {}; bf16x8 qr[12];
  const size_t qrow0 = (size_t)b * 2048 + qb * 256 + wid * 32;
  const bf16_t* Qw = Q + (qrow0 + r32) * 1536 + h * 192 + hi * 8;
#pragma unroll
  for (int d0 = 0; d0 < 12; ++d0) qr[d0] = __builtin_nontemporal_load(reinterpret_cast<const bf16x8*>(Qw + d0 * 16));
  const int vb0 = (int)(uintptr_t)lds + v_rd_base(lane);
  int ko[2], vo[2], ro;
#pragma unroll
  for (int e = 0; e < 2; ++e) { const int q = wid * 2 + e; const int krow = 4 * q + (lane >> 4); ko[e] = krow * 1024 + h * 128 + (((lane & 15) ^ (krow & 7)) * 8);
    const int st = 2 * q + (lane >> 5), kk = (st >> 2) * 8 + ((lane >> 2) & 7), k = (kk & ~0xC) | ((kk & 4) << 1) | ((kk & 8) >> 1); vo[e] = k * 1024 + h * 128 + (st & 3) * 32 + (lane & 3) * 8; }
  { const int rrow = 8 * wid + (lane >> 3); ro = rrow * 64 + (((lane & 7) ^ ((rrow >> 1) & 7)) * 8); }
#define TROW(t) ((size_t)((t) < 32 ? b * 2048 + (t) * 64 : 8192 + b * 256 + ((t) - 32) * 64))
#define DMA(t, vbuf) do { const size_t r0_ = TROW(t); const bf16_t* kb_ = KN + r0_ * 1024; const bf16_t* vb_ = V + r0_ * 1024; const bf16_t* rb_ = KR + r0_ * 64; const int kb2_ = ((t) & 1); \
    GLDS16(kb_ + ko[0], L3 + 49152 + kb2_ * 16384 + (wid * 2) * 1024); GLDS16(kb_ + ko[1], L3 + 49152 + kb2_ * 16384 + (wid * 2 + 1) * 1024); \
    GLDS16(vb_ + vo[0], L3 + (vbuf) + (wid * 2) * 1024); GLDS16(vb_ + vo[1], L3 + (vbuf) + (wid * 2 + 1) * 1024); \
    GLDS16(rb_ + ro, L3 + 81920 + kb2_ * 8192 + wid * 1024); } while (0)
#define RESC(a) do { if (__any((a) < 1.f)) { if (hi == 0) al_l[r32] = (a); asm volatile("s_waitcnt lgkmcnt(0)" ::: "memory"); \
    _Pragma("unroll") for (int d = 0; d < 4; ++d) _Pragma("unroll") for (int r = 0; r < 16; ++r) o[d][r] *= al_l[crow(r, hi)]; } } while (0)
#define TOPBAR() do { asm volatile("s_waitcnt vmcnt(0)" ::: "memory"); __syncthreads(); } while (0)
#define VNEXT(x) ((x) == 32768 ? 0 : (x) + 16384)
  f32x16 pA0, pA1, pB0, pB1; float mnA, mnB, alA, alB; bf16x8 pa0, pa1, pa2, pa3; constexpr int NT = 36;
  int v_prev = 0, v_cur = 16384, v_nxt = 32768;
  DMA(0, 0); TOPBAR();
  DMA(1, 16384);
  qkt(pA0, pA1, K_lds, R_lds, qr, r32, hi); partialSM(pA0, pA1, m_reg, mnA, alA);
  for (int j = 1; j + 1 < NT; j += 2) {
    TOPBAR(); DMA(j + 1, v_nxt);
    SBAR(); qkt(pB0, pB1, K_lds + 16384, R_lds + 8192, qr, r32, hi);
    finishSM(pA0, pA1, alA, l_reg, pa0, pa1, pa2, pa3); SBAR();
    pv_d0(o, vb0 + v_prev, pa0, pa1, pa2, pa3); partialSM(pB0, pB1, m_reg, mnB, alB);
    RESC(alB);
    v_prev = v_cur; v_cur = v_nxt; v_nxt = VNEXT(v_nxt);
    TOPBAR(); if (j + 2 < NT) DMA(j + 2, v_nxt);
    SBAR(); qkt(pA0, pA1, K_lds, R_lds, qr, r32, hi);
    finishSM(pB0, pB1, alB, l_reg, pa0, pa1, pa2, pa3); SBAR();
    pv_d0(o, vb0 + v_prev, pa0, pa1, pa2, pa3); partialSM(pA0, pA1, m_reg, mnA, alA);
    RESC(alA);
    v_prev = v_cur; v_cur = v_nxt; v_nxt = VNEXT(v_nxt);
  }
  TOPBAR();
  SBAR(); qkt(pB0, pB1, K_lds + 16384, R_lds + 8192, qr, r32, hi);
  finishSM(pA0, pA1, alA, l_reg, pa0, pa1, pa2, pa3); SBAR();
  pv_d0(o, vb0 + v_prev, pa0, pa1, pa2, pa3); partialSM(pB0, pB1, m_reg, mnB, alB);
  RESC(alB);
  finishSM(pB0, pB1, alB, l_reg, pa0, pa1, pa2, pa3); SBAR();
  pv_d0(o, vb0 + v_cur, pa0, pa1, pa2, pa3);
  if (hi == 0) li_l[r32] = l_reg; asm volatile("s_waitcnt lgkmcnt(0)" ::: "memory");
  bf16_t* Ow = O + qrow0 * 1024 + h * 128 + r32;
#pragma unroll
  for (int r = 0; r < 16; ++r) { const int orow = crow(r, hi); const float rl = __builtin_amdgcn_rcpf(li_l[orow]);
#pragma unroll
    for (int d0 = 0; d0 < 4; ++d0) Ow[(size_t)orow * 1024 + d0 * 32] = (bf16_t)(cvtpk(o[d0][r] * rl, 0.f) & 0xffffu); }
  __syncthreads();
#undef TROW
#undef DMA
#undef RESC
#undef TOPBAR
#undef VNEXT
}
#undef SBAR
}

constexpr int S5_UL = 0, S5_UST = 1040, S5_HL = 75776, S5_HST = 528;
__device__ __forceinline__ float gelu_t(float x) { return x * sigm(1.5957691216057308f * x * (1.f + 0.044715f * x * x)); }
__device__ __forceinline__ void s5_unit(int g, int b, const bf16_t* __restrict__ Ub, const bf16_t* __restrict__ Kcomb, const bf16_t* __restrict__ Wtab, const bf16_t* __restrict__ Vtab,
                                        const float* a_re, const float* a_im, const float* log_dt, bf16_t* __restrict__ Z, LAS unsigned char* lds) {
    const int tid = opaque_tid(), lane = tid & 63, wave = __builtin_amdgcn_readfirstlane(tid >> 6), i = lane & 31, hi = lane >> 5;
    for (int idx = tid; idx < 4608; idx += 512) { const int tau = idx >> 1, half = idx & 1; const size_t row = tau < 256 ? (size_t)8192 + b * 256 + tau : (size_t)b * 2048 + tau - 256;
        *(LAS u32x4*)(lds + S5_UL + (tau >> 5) * S5_UST + (tau & 31) * 32 + half * 16) = *(const u32x4*)(Ub + row * 1024 + g * 16 + half * 8); }
    __syncthreads();
    {
        f32x16 a0 = {}, a1 = {}, a2 = {};
        const bf16_t* wt = Wtab + (size_t)g * 32 * 4096 + (wave * 32 + i) * 16 + hi * 8;
        const int c2 = (64 + i) < 72 ? 64 + i : 71;
        const LAS unsigned char* u0 = lds + S5_UL + i * S5_UST + hi * 16; const LAS unsigned char* u1 = lds + S5_UL + (32 + i) * S5_UST + hi * 16; const LAS unsigned char* u2 = lds + S5_UL + c2 * S5_UST + hi * 16;
#pragma unroll 16
        for (int s = 0; s < 32; ++s) { const bf16x8 af = *(const bf16x8*)(wt + s * 4096);
            a0 = __builtin_amdgcn_mfma_f32_32x32x16_bf16(af, *(const LAS bf16x8*)(u0 + s * 32), a0, 0, 0, 0);
            a1 = __builtin_amdgcn_mfma_f32_32x32x16_bf16(af, *(const LAS bf16x8*)(u1 + s * 32), a1, 0, 0, 0);
            a2 = __builtin_amdgcn_mfma_f32_32x32x16_bf16(af, *(const LAS bf16x8*)(u2 + s * 32), a2, 0, 0, 0); }
#pragma unroll
        for (int rr = 0; rr < 4; ++rr) { const int np = wave * 32 + 8 * rr + 4 * hi; u32x2 w;
            w.x = cvtpk(a0[4 * rr], a0[4 * rr + 1]); w.y = cvtpk(a0[4 * rr + 2], a0[4 * rr + 3]); *(LAS u32x2*)(lds + S5_HL + i * S5_HST + np * 2) = w;
            w.x = cvtpk(a1[4 * rr], a1[4 * rr + 1]); w.y = cvtpk(a1[4 * rr + 2], a1[4 * rr + 3]); *(LAS u32x2*)(lds + S5_HL + (32 + i) * S5_HST + np * 2) = w;
            w.x = cvtpk(a2[4 * rr], a2[4 * rr + 1]); w.y = cvtpk(a2[4 * rr + 2], a2[4 * rr + 3]); if (64 + i < 72) *(LAS u32x2*)(lds + S5_HL + (64 + i) * S5_HST + np * 2) = w; }
    }
    __syncthreads();
    if (wave < 2) { const int d = wave, n = lane, base = (d * 64 + g) * 64 + n; const Cx A32 = cpowk(a_re[base], a_im[base], __expf(log_dt[d * 64 + g]), 32.f);
        float hr = 0.f, him = 0.f; LAS unsigned char* hb = lds + S5_HL + (d * 128 + n) * 2;
#pragma unroll 4
        for (int st = 0; st < 72; ++st) { const int col = d == 0 ? st : (st < 8 ? 7 - st : 79 - st);
            LAS unsigned short* pr = (LAS unsigned short*)(hb + col * S5_HST); LAS unsigned short* pi = pr + 64;
            const float sre = bf2f(*pr), sim = bf2f(*pi);
            *pr = (unsigned short)(cvtpk(hr, 0.f) & 0xffffu); *pi = (unsigned short)(cvtpk(him, 0.f) & 0xffffu);
            const float nr = A32.re * hr - A32.im * him + sre, ni = A32.re * him + A32.im * hr + sim; hr = nr; him = ni; }
    }
    __syncthreads();
    f32x16 y00 = {}, y01 = {}, y10 = {}, y11 = {};
    {
        const int rb0 = 2 * wave;
        const bf16_t* kc = Kcomb + (size_t)g * 64 * 256 + (i >> 4) * 256 + (i & 15) * 16 + hi * 8;
        const LAS unsigned char* u0 = lds + S5_UL + (8 + i) * S5_UST + hi * 16; const LAS unsigned char* u1 = lds + S5_UL + (40 + i) * S5_UST + hi * 16;
#pragma unroll 16
        for (int s = 0; s < 32; ++s) { const bf16x8 f0 = *(const bf16x8*)(kc + (2 * rb0 - s + 32) * 256), f1 = *(const bf16x8*)(kc + (2 * rb0 + 2 - s + 32) * 256);
            const bf16x8 b0 = *(const LAS bf16x8*)(u0 + s * 32), b1 = *(const LAS bf16x8*)(u1 + s * 32);
            y00 = __builtin_amdgcn_mfma_f32_32x32x16_bf16(f0, b0, y00, 0, 0, 0); y01 = __builtin_amdgcn_mfma_f32_32x32x16_bf16(f0, b1, y01, 0, 0, 0);
            y10 = __builtin_amdgcn_mfma_f32_32x32x16_bf16(f1, b0, y10, 0, 0, 0); y11 = __builtin_amdgcn_mfma_f32_32x32x16_bf16(f1, b1, y11, 0, 0, 0); }
        const bf16_t* vt = Vtab + ((size_t)g * 16 + rb0) * 16 * 512 + i * 16 + hi * 8;
        const LAS unsigned char* h0 = lds + S5_HL + (8 + i) * S5_HST + hi * 16; const LAS unsigned char* h1 = lds + S5_HL + (40 + i) * S5_HST + hi * 16;
#pragma unroll 16
        for (int kk = 0; kk < 16; ++kk) { const bf16x8 f0 = *(const bf16x8*)(vt + kk * 512), f1 = *(const bf16x8*)(vt + 16 * 512 + kk * 512);
            const bf16x8 b0 = *(const LAS bf16x8*)(h0 + kk * 32), b1 = *(const LAS bf16x8*)(h1 + kk * 32);
            y00 = __builtin_amdgcn_mfma_f32_32x32x16_bf16(f0, b0, y00, 0, 0, 0); y01 = __builtin_amdgcn_mfma_f32_32x32x16_bf16(f0, b1, y01, 0, 0, 0);
            y10 = __builtin_amdgcn_mfma_f32_32x32x16_bf16(f1, b0, y10, 0, 0, 0); y11 = __builtin_amdgcn_mfma_f32_32x32x16_bf16(f1, b1, y11, 0, 0, 0); }
    }
    __syncthreads();
    {
        LAS unsigned char* zs = lds + S5_UL + wave * 8192;
#define S5_ST(ACC, RBI, NB) _Pragma("unroll") for (int rr = 0; rr < 4; ++rr) { const int tl = (RBI) * 2 + (rr >> 1), p0 = 8 * (rr & 1) + 4 * hi, ch = 32 * (NB) + i; u32x2 w; \
            w.x = cvtpk(gelu_t(ACC[4 * rr]), gelu_t(ACC[4 * rr + 1])); w.y = cvtpk(gelu_t(ACC[4 * rr + 2]), gelu_t(ACC[4 * rr + 3])); *(LAS u32x2*)(zs + (tl * 64 + ch) * 32 + p0 * 2) = w; }
        S5_ST(y00, 0, 0) S5_ST(y01, 0, 1) S5_ST(y10, 1, 0) S5_ST(y11, 1, 1)
#undef S5_ST
        LDS_WAIT();
#pragma unroll
        for (int j = 0; j < 8; ++j) { const int tok = j * 32 + (lane >> 1), half = lane & 1, tl = tok >> 6, ch = tok & 63; const u32x4 v = *(const LAS u32x4*)(zs + tok * 32 + half * 16);
            *(u32x4*)(Z + ((size_t)b * 2048 + ch * 32 + 4 * wave + tl) * 1024 + g * 16 + half * 8) = v; }
    }
    __syncthreads();
}

__global__ void __launch_bounds__(512) fwd_kernel(Params P) {
    extern __shared__ __attribute__((aligned(16))) unsigned char lds[];
    cg::grid_group grid = cg::this_grid();
    LAS unsigned char* L = (LAS unsigned char*)lds;
    const int G = gridDim.x, bx = blockIdx.x, vcu = (G % 8 == 0) ? (bx % 8) * (G / 8) + bx / 8 : bx;
    const int NGW = G * 8;
    unsigned char* ws = P.ws;
    float* CTL = (float*)(ws + WS_CTL); float* MOD = (float*)(ws + WS_MOD); float* BIAS2 = (float*)(ws + WS_BIAS2);
    bf16_t *Wt_in = (bf16_t*)(ws + WS_WIN), *Wt_glu = (bf16_t*)(ws + WS_WGLU), *Wt_uq = (bf16_t*)(ws + WS_WUQ), *Wt_ukv = (bf16_t*)(ws + WS_WUKV), *Wt_mo = (bf16_t*)(ws + WS_WMO),
           *Wt_out = (bf16_t*)(ws + WS_WOUT), *Wt_f1 = (bf16_t*)(ws + WS_WF1), *Wt_f2 = (bf16_t*)(ws + WS_WF2);
    bf16_t *GATES = (bf16_t*)(ws + WS_GATES), *XMOD = (bf16_t*)(ws + WS_XMOD), *Ub = (bf16_t*)(ws + WS_U), *CQKV = (bf16_t*)(ws + WS_CQKV), *KR = (bf16_t*)(ws + WS_KR),
           *Kcomb = (bf16_t*)(ws + WS_KCOMB), *Wtab = (bf16_t*)(ws + WS_WTAB), *Vtab = (bf16_t*)(ws + WS_VTAB), *Qb = (bf16_t*)(ws + WS_Q), *KN = (bf16_t*)(ws + WS_KN), *Vb = (bf16_t*)(ws + WS_V),
           *Zb = (bf16_t*)(ws + WS_Z), *Ob = (bf16_t*)(ws + WS_O), *S5P = (bf16_t*)(ws + WS_S5P), *MIX = (bf16_t*)(ws + WS_MIX), *X1S = (bf16_t*)(ws + WS_X1S), *ACT = (bf16_t*)(ws + WS_ACT);
    float* X1 = (float*)(ws + WS_X1);
    const float *a_re = P.in[I_ARE], *a_im = P.in[I_AIM], *log_dt = P.in[I_LOGDT], *b_re = P.in[I_BRE], *b_im = P.in[I_BIM], *c_re = P.in[I_CRE], *c_im = P.in[I_CIM];

#ifndef PROBE_REP
#define PROBE_REP 0
#endif
    const bool split = (G == 256);
    { volatile LAS unsigned* st_ = (volatile LAS unsigned*)(L + 147392); if (threadIdx.x == 0) { st_[0] = 0u; st_[1] = 0u; } __syncthreads(); }
    const XcdBarrier xbar = xcd_barrier_post((unsigned*)(CTL + 131072), (volatile LAS unsigned*)(L + 147392));
    if (PROBE_REP & 1024) { for (int q_ = 0; q_ < 8; ++q_) xcd_barrier(xbar); }
    for (int rep_ = 0; rep_ < ((PROBE_REP & 1) ? 2 : 1); ++rep_) {
    {
        const int tid = opaque_tid(), lane = tid & 63, wave = __builtin_amdgcn_readfirstlane(tid >> 6);
        if (!split || bx < 192) {
        LAS float* scl = (LAS float*)L;
        LAS f32x4* red = (LAS f32x4*)(L + 40960);
        for (int i = tid; i < 5 * 2048; i += 512) { const int v = i >> 11, k = i & 2047; const float cv = v < 4 ? P.in[I_C][v * 2048 + k] : P.in[I_CCTX][k]; scl[i] = cv * sigm(cv); }
        __syncthreads();
        for (int rp2_ = 0; rp2_ < ((PROBE_REP & 128) ? 2 : 1); ++rp2_)
        for (int item = bx; item < 192; item += G) {
            const int n0 = item * 64, c4 = lane & 15, rsub = lane >> 4;
            f32x4 a[5];
#pragma unroll
            for (int v = 0; v < 5; ++v) a[v] = (f32x4){0.f, 0.f, 0.f, 0.f};
            const float* wp = P.in[I_WMOD] + (size_t)(wave * 4 + rsub) * 12288 + n0 + c4 * 4;
#pragma unroll 8
            for (int it = 0; it < 64; ++it) { const int k = wave * 4 + rsub + 32 * it; const f32x4 w = __builtin_nontemporal_load((const f32x4*)(wp + (size_t)it * 32 * 12288));
#pragma unroll
                for (int v = 0; v < 5; ++v) a[v] += w * scl[v * 2048 + k]; }
#pragma unroll
            for (int v = 0; v < 5; ++v)
#pragma unroll
                for (int e = 0; e < 4; ++e) { float t = a[v][e]; t += __shfl_xor(t, 16); t += __shfl_xor(t, 32); a[v][e] = t; }
            if (lane < 16) {
#pragma unroll
                for (int v = 0; v < 5; ++v) red[(wave * 16 + c4) * 5 + v] = a[v]; }
            __syncthreads();
            if (tid < 80) { const int cc = tid & 15, v = tid >> 4; f32x4 s = *(const f32x4*)(P.in[I_BMOD] + n0 + cc * 4);
#pragma unroll
                for (int w = 0; w < 8; ++w) s += red[(w * 16 + cc) * 5 + v];
                float* mp = MOD + (size_t)v * 12288 + n0 + cc * 4;
                __hip_atomic_store(mp, s[0], __ATOMIC_RELAXED, __HIP_MEMORY_SCOPE_AGENT); __hip_atomic_store(mp + 1, s[1], __ATOMIC_RELAXED, __HIP_MEMORY_SCOPE_AGENT);
                __hip_atomic_store(mp + 2, s[2], __ATOMIC_RELAXED, __HIP_MEMORY_SCOPE_AGENT); __hip_atomic_store(mp + 3, s[3], __ATOMIC_RELAXED, __HIP_MEMORY_SCOPE_AGENT); }
            asm volatile("s_waitcnt vmcnt(0)" ::: "memory");
            __syncthreads();
            if (tid == 0 && item < 64) __hip_atomic_fetch_add((unsigned*)(CTL + 150000), 1u, __ATOMIC_RELAXED, __HIP_MEMORY_SCOPE_AGENT);
        }
        }
        if (!split || bx >= 192) {
        __syncthreads();
        LAS float* scr = (LAS float*)(L + wave * 16640);
        const int w0 = (split ? bx - 192 : bx) * 8 + wave, nw = (split ? 64 : G) * 8;
        auto dec_in = [&](int it) { TrItem t; t.nt = false; t.bias_sh = nullptr; t.bias_out = nullptr; const int kb = it / 93, n0 = (it % 93) * 64; t.W = P.in[I_WIN]; t.kscale = nullptr; t.WT = Wt_in; t.N = 5952; t.k0 = kb * 64; t.n0 = n0; t.ldt = 2048; t.drow0 = n0 < 1856 ? n0 : n0 + 192; t.rperm = (n0 == 1792); return t; };
        for (int rp4_ = 0; rp4_ < ((PROBE_REP & 512) ? 2 : 1); ++rp4_)
        TR_LOOP(dec_in, w0, 32 * 93, nw);
        for (int i = w0 * 64 + lane; i < 192 * 2048 / 8; i += nw * 64) *(u32x4*)(Wt_in + (size_t)1856 * 2048 + (size_t)i * 8) = (u32x4){0u, 0u, 0u, 0u};
        }
    }
    if (split) __syncthreads(); else grid.sync();
    }
    for (int rep_ = 0; rep_ < ((PROBE_REP & 32) ? 2 : 1); ++rep_) {
    {
        const int tid = opaque_tid(), lane = tid & 63, wave = __builtin_amdgcn_readfirstlane(tid >> 6);
        if (wave >= 4) {
        const int w0 = bx * 4 + (wave - 4), nw = G * 4; LAS float* scr = (LAS float*)(L + (wave - 4) * 8704);
        for (int it = w0; it < 64 * 63; it += nw) { const int g = it / 63, e = it % 63 + 1, dd = e - 32, p = lane >> 2, q0 = (lane & 3) * 4; float acc[4] = {0.f, 0.f, 0.f, 0.f};
            for (int d = 0; d < 2; ++d) { if ((dd > 0 && d == 1) || (dd < 0 && d == 0)) continue;
                { const int n = lane, base = (d * 64 + g) * 64 + n; const float lr = a_re[base], li = a_im[base], dt = __expf(log_dt[d * 64 + g]); const Cx co = s5_coef(lr, li, dt), pw = cpowk(lr, li, dt, (float)(dd < 0 ? -dd : dd));
                    scr[2 * n] = pw.re; scr[2 * n + 1] = pw.im;
#pragma unroll
                    for (int q = 0; q < 16; q += 4) { const f32x4 brv = *(const f32x4*)(b_re + (size_t)base * 16 + q), biv = *(const f32x4*)(b_im + (size_t)base * 16 + q);
#pragma unroll
                        for (int j = 0; j < 4; ++j) { Cx bq; bq.re = brv[j]; bq.im = biv[j]; const Cx bb = cmul(co, bq); scr[128 + n * 16 + q + j] = bb.re; scr[1152 + n * 16 + q + j] = bb.im; } } }
                LDS_WAIT();
                const float* cr = c_re + ((size_t)(d * 64 + g) * 16 + p) * 64; const float* cim = c_im + ((size_t)(d * 64 + g) * 16 + p) * 64;
#pragma unroll 4
                for (int n4 = 0; n4 < 64; n4 += 4) { const f32x4 crv = *(const f32x4*)(cr + n4), civ = *(const f32x4*)(cim + n4);
#pragma unroll
                    for (int e2 = 0; e2 < 4; ++e2) { const int n2 = n4 + e2; Cx c; c.re = crv[e2]; c.im = civ[e2]; Cx pn; pn.re = scr[2 * n2]; pn.im = scr[2 * n2 + 1]; const Cx ca = cmul(c, pn);
                        const f32x4 bre = *(const LAS f32x4*)(scr + 128 + n2 * 16 + q0), bim = *(const LAS f32x4*)(scr + 1152 + n2 * 16 + q0);
#pragma unroll
                        for (int j = 0; j < 4; ++j) acc[j] += ca.re * bre[j] - ca.im * bim[j]; } }
                LDS_WAIT();
            }
            if (dd == 0) { const float dsk = P.in[I_D][g * 16 + p];
#pragma unroll
                for (int j = 0; j < 4; ++j) if (q0 + j == p) acc[j] += dsk; }
            u32x2 w; w.x = cvtpk(acc[0], acc[1]); w.y = cvtpk(acc[2], acc[3]); *(u32x2*)(Kcomb + ((size_t)(g * 64 + e) * 16 + p) * 16 + q0) = w; }
            } else {
        if (split) { unsigned sp = 0; while ((unsigned)__builtin_amdgcn_readfirstlane(__hip_atomic_load((unsigned*)(CTL + 150000), __ATOMIC_RELAXED, __HIP_MEMORY_SCOPE_AGENT)) < 64u) { __builtin_amdgcn_s_sleep(2); if (++sp > (1u << 20)) break; }
            __builtin_amdgcn_fence(__ATOMIC_ACQUIRE, "agent"); }
        const int gw = bx * 4 + wave, NGW4 = G * 4;
        for (int row = gw; row < 9216; row += 2 * NGW4) { const int row2 = row + NGW4; const bool has2 = row2 < 9216; const int rB = has2 ? row2 : row;
            const float* srcA = row < 8192 ? P.in[I_X] + (size_t)row * 2048 : P.in[I_CTX] + (size_t)(row - 8192) * 2048; const int vA = row < 8192 ? row >> 11 : 4;
            const float* srcB = rB < 8192 ? P.in[I_X] + (size_t)rB * 2048 : P.in[I_CTX] + (size_t)(rB - 8192) * 2048; const int vB = rB < 8192 ? rB >> 11 : 4;
            f32x4 xa[8], xb[8]; float sa = 0.f, sb = 0.f;
#pragma unroll
            for (int j = 0; j < 8; ++j) xa[j] = __builtin_nontemporal_load((const f32x4*)srcA + 64 * j + lane);
#pragma unroll
            for (int j = 0; j < 8; ++j) xb[j] = __builtin_nontemporal_load((const f32x4*)srcB + 64 * j + lane);
#pragma unroll
            for (int j = 0; j < 8; ++j) { sa += dot4(xa[j]); sb += dot4(xb[j]); }
            const float rsA = __builtin_amdgcn_rsqf(wave_sum(sa) * (1.f / 2048.f) + 1e-6f), rsB = __builtin_amdgcn_rsqf(wave_sum(sb) * (1.f / 2048.f) + 1e-6f);
            const float* modA = MOD + (size_t)vA * 12288; const float* modB = MOD + (size_t)vB * 12288;
#pragma unroll
            for (int j = 0; j < 8; ++j) { const int c = (64 * j + lane) * 4; const f32x4 n1 = *(const f32x4*)(P.in[I_NORM1] + c);
                const f32x4 oa = xa[j] * rsA * n1 * (*(const f32x4*)(modA + 2048 + c) + 1.f) + *(const f32x4*)(modA + c);
                u32x2 w; w.x = cvtpk(oa[0], oa[1]); w.y = cvtpk(oa[2], oa[3]); *(u32x2*)(XMOD + (size_t)row * 2048 + c) = w;
                if (has2) { const f32x4 ob = xb[j] * rsB * n1 * (*(const f32x4*)(modB + 2048 + c) + 1.f) + *(const f32x4*)(modB + c);
                    u32x2 w2; w2.x = cvtpk(ob[0], ob[1]); w2.y = cvtpk(ob[2], ob[3]); *(u32x2*)(XMOD + (size_t)row2 * 2048 + c) = w2; } } }
        }
    }
    xcd_barrier(xbar);
    }
    for (int rq_ = 0; rq_ < ((PROBE_REP & 8) ? 2 : 1); ++rq_)
    { pg8::Gemm g{XMOD, Wt_in, 9216, 6144, 2048, 2048, 2048}; pg8::P1Order S; S.init(G, bx);
      pg8::EpiIn E{Ub, CQKV, KR, GATES, CTL + SSQ_Q + rq_ * 65536, CTL + SSQ_KV + rq_ * 65536}; pg8::gemm_phase<pg8::EpiIn, pg8::P1Order, true, true>(L, g, S, E); }
    for (int rep_ = 0; rep_ < ((PROBE_REP & 64) ? 2 : 1); ++rep_)
    if (!split || bx >= 32) {
        const int tid = opaque_tid(), lane = tid & 63, wave = __builtin_amdgcn_readfirstlane(tid >> 6);
        const int w0 = (split ? bx - 32 : bx) * 8 + wave, nw = (split ? 224 : G) * 8;
        LAS float* scr = (LAS float*)(L + wave * 16640);
        constexpr int I_GLU = 16 * 64, I_UQ = 8 * 24, I_UKV = 4 * 32, I_MO = 16 * 32, I_OUT = 32 * 32, I_F1 = 32 * 176, I_F2 = 88 * 32;
        constexpr int NITEMS = I_GLU + I_UQ + I_UKV + I_MO + I_OUT + I_F1;
        auto dec_sh = [&](int it) { TrItem t; t.kscale = nullptr; t.rperm = false; t.nt = true; t.bias_sh = nullptr; t.bias_out = nullptr; int r = it;
            if (r < I_UQ) { const int kb = r / 24, n0 = (r % 24) * 64; t.W = P.in[I_WUQ]; t.kscale = P.in[I_QNORM]; t.WT = Wt_uq; t.N = 1536; t.k0 = kb * 64; t.n0 = n0; t.ldt = 512; t.drow0 = n0; t.rperm = (n0 % 192) == 128; return t; } r -= I_UQ;
            if (r < I_UKV) { const int kb = r / 32, n0 = (r % 32) * 64; t.W = P.in[I_WUKV]; t.kscale = P.in[I_KVNORM]; t.WT = Wt_ukv; t.N = 2048; t.k0 = kb * 64; t.n0 = n0; t.ldt = 256; t.drow0 = n0; return t; } r -= I_UKV;
            if (r < I_GLU) { const int kb = r / 64, n0 = (r % 64) * 64, j0 = n0 & 2047, hf = n0 >> 11; t.W = P.in[I_WGLU]; t.WT = Wt_glu; t.N = 4096; t.k0 = kb * 64; t.n0 = n0; t.ldt = 1024; t.drow0 = (j0 >> 7) * 256 + hf * 128 + (j0 & 127); return t; } r -= I_GLU;
            if (r < I_MO) { const int kb = r / 32, n0 = (r % 32) * 64; t.W = P.in[I_WMO]; t.WT = Wt_mo; t.N = 2048; t.k0 = kb * 64; t.n0 = n0; t.ldt = 1024; t.drow0 = n0; return t; } r -= I_MO;
            if (r < I_OUT) { const int kb = r / 32, n0 = (r % 32) * 64; t.W = P.in[I_WOUT]; t.WT = Wt_out; t.N = 2048; t.k0 = kb * 64; t.n0 = n0; t.ldt = 2048; t.drow0 = n0; return t; } r -= I_OUT;
            { const int kb = r / 176, n0 = (r % 176) * 64, j0 = n0 % 5632, hf = n0 / 5632; t.W = P.in[I_WF1]; t.WT = Wt_f1; t.N = 11264; t.k0 = kb * 64; t.n0 = n0; t.ldt = 2048; t.drow0 = (j0 >> 7) * 256 + hf * 128 + (j0 & 127); t.bias_sh = MOD + 3 * 2048; t.bias_out = BIAS2 + t.drow0; return t; } };
        TR_LOOP(dec_sh, w0, NITEMS, nw);
        for (int it = w0; it < 2048; it += nw) { const int g = it >> 5, s = it & 31, n = lane;
#pragma unroll
            for (int d = 0; d < 2; ++d) { const int base = (d * 64 + g) * 64 + n; const float lr = a_re[base], li = a_im[base], dt = __expf(log_dt[d * 64 + g]);
                const Cx pc = cmul(cpowk(lr, li, dt, d == 0 ? (float)(31 - s) : (float)s), s5_coef(lr, li, dt));
                const float* br = b_re + (size_t)base * 16; const float* bi = b_im + (size_t)base * 16; unsigned wre[8], wim[8];
#pragma unroll
                for (int q = 0; q < 16; q += 2) { Cx b0; b0.re = br[q]; b0.im = bi[q]; Cx b1; b1.re = br[q + 1]; b1.im = bi[q + 1]; const Cx v0 = cmul(pc, b0), v1 = cmul(pc, b1);
                    wre[q >> 1] = cvtpk(v0.re, v1.re); wim[q >> 1] = cvtpk(v0.im, v1.im); }
                bf16_t* dst = Wtab + ((size_t)(g * 32 + s) * 256 + d * 128 + n) * 16;
                *(u32x4*)dst = (u32x4){wre[0], wre[1], wre[2], wre[3]}; *(u32x4*)(dst + 8) = (u32x4){wre[4], wre[5], wre[6], wre[7]};
                *(u32x4*)(dst + 1024) = (u32x4){wim[0], wim[1], wim[2], wim[3]}; *(u32x4*)(dst + 1032) = (u32x4){wim[4], wim[5], wim[6], wim[7]}; } }
        for (int it = w0; it < 1024; it += nw) { const int g = it >> 4, kk = it & 15, i = lane & 31, hi = lane >> 5, th = i >> 4, p = i & 15, blk = kk >> 2, d = blk >> 1, isim = blk & 1, nb0 = (kk & 3) * 16 + 8 * hi;
            const float dt = __expf(log_dt[d * 64 + g]), e0 = d == 0 ? (float)(th + 1) : (float)(2 - th); const int base = (d * 64 + g) * 64 + nb0, ci = ((d * 64 + g) * 16 + p) * 64 + nb0;
            const f32x4 ar0 = *(const f32x4*)(a_re + base), ar1 = *(const f32x4*)(a_re + base + 4), ai0 = *(const f32x4*)(a_im + base), ai1 = *(const f32x4*)(a_im + base + 4);
            const f32x4 cr0 = *(const f32x4*)(c_re + ci), cr1 = *(const f32x4*)(c_re + ci + 4), ci0 = *(const f32x4*)(c_im + ci), ci1 = *(const f32x4*)(c_im + ci + 4);
            Cx pw[8], a2[8], cc[8];
#pragma unroll
            for (int j = 0; j < 8; ++j) { const float lr = j < 4 ? ar0[j & 3] : ar1[j & 3], li = j < 4 ? ai0[j & 3] : ai1[j & 3]; pw[j] = cpowk(lr, li, dt, e0); a2[j] = cpowk(lr, li, dt, 2.f); cc[j].re = j < 4 ? cr0[j & 3] : cr1[j & 3]; cc[j].im = j < 4 ? ci0[j & 3] : ci1[j & 3]; }
            for (int st = 0; st < 16; ++st) { const int rb = d == 0 ? st : 15 - st; float val[8];
#pragma unroll
                for (int j = 0; j < 8; ++j) { val[j] = isim ? -(cc[j].re * pw[j].im + cc[j].im * pw[j].re) : (cc[j].re * pw[j].re - cc[j].im * pw[j].im); pw[j] = cmul(pw[j], a2[j]); }
                *(u32x4*)(Vtab + ((((size_t)g * 16 + rb) * 16 + kk) * 32 + i) * 16 + 8 * hi) = (u32x4){cvtpk(val[0], val[1]), cvtpk(val[2], val[3]), cvtpk(val[4], val[5]), cvtpk(val[6], val[7])}; } }
    }
    xcd_barrier(xbar);
    for (int rep_ = 0; rep_ < ((PROBE_REP & 4) ? 2 : 1); ++rep_)
    for (int u = vcu; u < 256; u += G) s5_unit(u & 63, u >> 6, Ub, Kcomb, Wtab, Vtab, a_re, a_im, log_dt, Zb, L);
    for (int rq_ = 0; rq_ < ((PROBE_REP & 8192) ? 2 : 1); ++rq_)
    { pg8::Gemm g{CQKV, Wt_uq, 8192, 1536, 512, 768, 512}; pg8::StaticOrder S; S.init(8192, 1536, G, bx);
      pg8::EpiQ E{Qb, CTL + SSQ_Q}; pg8::gemm_phase<pg8::EpiQ, pg8::StaticOrder, true, true>(L, g, S, E); }
    __syncthreads();
    for (int rq_ = 0; rq_ < ((PROBE_REP & 8192) ? 2 : 1); ++rq_)
    { pg8::Gemm g{CQKV + 512, Wt_ukv, 9216, 2048, 256, 768, 256}; pg8::StaticOrder S; S.init(9216, 2048, G, (bx + 64) % G);
      pg8::EpiKV E{KN, Vb, CTL + SSQ_KV}; pg8::gemm_phase<pg8::EpiKV, pg8::StaticOrder, true, true>(L, g, S, E); }
    xcd_barrier(xbar);
    for (int rep_ = 0; rep_ < ((PROBE_REP & 2) ? 2 : 1); ++rep_)
    for (int u = vcu; u < 256; u += G) att::attn_unit(u >> 6, (u >> 3) & 7, u & 7, Qb, KN, KR, Vb, Ob, (char*)lds, L);
    for (int rq_ = 0; rq_ < ((PROBE_REP & 2048) ? 2 : 1); ++rq_)
    { pg8::Gemm g{Zb, Wt_glu, 8192, 4096, 1024, 1024, 1024}; pg8::StaticOrder S; S.init(8192, 4096, G, bx);
      pg8::EpiGlu E{S5P, GATES}; pg8::gemm_phase<pg8::EpiGlu, pg8::StaticOrder, true, true>(L, g, S, E); }
    xcd_barrier(xbar);
    for (int rq_ = 0; rq_ < ((PROBE_REP & 4096) ? 2 : 1); ++rq_)
    { pg8::Gemm g{Ob, Wt_mo, 8192, 2048, 1024, 1024, 1024}; pg8::StaticOrder S; S.init(8192, 2048, G, bx);
      pg8::EpiMix E{S5P, GATES, MIX}; pg8::gemm_phase<pg8::EpiMix, pg8::StaticOrder, true, true>(L, g, S, E); }
    xcd_barrier(xbar);
    for (int rq_ = 0; rq_ < ((PROBE_REP & 16384) ? 2 : 1); ++rq_)
    { pg8::Gemm g{MIX, Wt_out, 8192, 2048, 2048, 2048, 2048}; pg8::StaticOrder S; S.init(8192, 2048, G, bx);
      pg8::EpiOut E{P.in[I_X], MOD, P.in[I_NORM2], X1, CTL + SSQ_1 + rq_ * 65536, X1S}; pg8::gemm_phase<pg8::EpiOut, pg8::StaticOrder, true, true>(L, g, S, E); }
    xcd_barrier(xbar);
    for (int rep_ = 0; rep_ < ((PROBE_REP & 16) ? 2 : 1); ++rep_)
    { pg8::Gemm g{X1S, Wt_f1, 8192, 11264, 2048, 2048, 2048}; pg8::StaticOrder S; S.init(8192, 11264, G, bx);
      pg8::EpiFfn1 E{CTL + SSQ_1, BIAS2, ACT}; pg8::gemm_phase<pg8::EpiFfn1, pg8::StaticOrder, true, true>(L, g, S, E); }
    if (!split || bx >= 128) {
        const int tid = opaque_tid(), lane = tid & 63, wave = __builtin_amdgcn_readfirstlane(tid >> 6);
        const int w0 = (split ? bx - 128 : bx) * 8 + wave, nw = (split ? 128 : G) * 8;
        LAS float* scr = (LAS float*)(L + wave * 16640);
        auto dec_f2 = [&](int it) { TrItem t; t.kscale = nullptr; t.rperm = false; t.nt = false; t.bias_sh = nullptr; t.bias_out = nullptr; const int kb = it / 32, n0 = (it % 32) * 64; t.W = P.in[I_WF2]; t.WT = Wt_f2; t.N = 2048; t.k0 = kb * 64; t.n0 = n0; t.ldt = 5632; t.drow0 = n0; return t; };
        TR_LOOP(dec_f2, w0, 88 * 32, nw);
    }
    xcd_barrier(xbar);
    for (int rq_ = 0; rq_ < ((PROBE_REP & 32768) ? 2 : 1); ++rq_)
    { pg8::Gemm g{ACT, Wt_f2, 8192, 2048, 5632, 5632, 5632}; pg8::StaticOrder S; S.init(8192, 2048, G, bx);
      pg8::EpiFfn2 E{X1, MOD, P.in[I_NORMF], P.out, CTL + SSQ_2 + rq_ * 65536, (unsigned*)(CTL + 140000) + rq_ * 4096, split ? 1 : 0}; pg8::gemm_phase<pg8::EpiFfn2, pg8::StaticOrder, true, true>(L, g, S, E); }
    if (!split) {
    xcd_barrier(xbar);
    { const int tid = opaque_tid(), lane = tid & 63, wave = __builtin_amdgcn_readfirstlane(tid >> 6), gw = bx * 8 + wave;
    for (int row = gw; row < 8192; row += NGW) { const float rstd = __builtin_amdgcn_rsqf(CTL[SSQ_2 + row] * (1.f / 2048.f) + 1e-6f); f32x4* o = (f32x4*)(P.out + (size_t)row * 2048);
#pragma unroll
        for (int j = 0; j < 8; ++j) { const int c4 = 64 * j + lane; o[c4] = o[c4] * rstd * *(const f32x4*)(P.in[I_NORMF] + c4 * 4); } } }
    }
}

extern "C" void kernel_launch(void* const* d_in, const int* in_sizes, int n_in, void* d_out, int out_size, void* d_ws, size_t ws_size, hipStream_t stream) {
    static int grid = 0;
    if (grid == 0) {
        if (n_in != 27 || out_size != 8192 * 2048 || ws_size < WS_END) { fprintf(stderr, "kernel_launch: unexpected shapes (n_in %d out %d ws %zu)\n", n_in, out_size, ws_size); grid = -1; return; }
        int dev = 0, cus = 0, per_cu = 0;
        if (hipGetDevice(&dev) != hipSuccess || hipDeviceGetAttribute(&cus, hipDeviceAttributeMultiprocessorCount, dev) != hipSuccess) { grid = -1; return; }
        if (hipFuncSetAttribute((const void*)fwd_kernel, hipFuncAttributeMaxDynamicSharedMemorySize, LDS_BYTES) != hipSuccess) { fprintf(stderr, "kernel_launch: hipFuncSetAttribute failed\n"); grid = -1; return; }
        if (hipOccupancyMaxActiveBlocksPerMultiprocessor(&per_cu, (const void*)fwd_kernel, 512, LDS_BYTES) != hipSuccess || per_cu < 1) { fprintf(stderr, "kernel_launch: occupancy query gave %d\n", per_cu); per_cu = 1; }
        (void)hipGetLastError();
        grid = cus * per_cu;
    }
    if (grid < 0) return;
    (void)hipMemsetAsync((char*)d_ws + WS_CTL, 0, 2 * CTL_BYTES, stream);
    Params p{};
    for (int i = 0; i < 27; ++i) p.in[i] = (const float*)d_in[i];
    p.out = (float*)d_out; p.ws = (unsigned char*)d_ws;
    void* args[] = {&p};
    const hipError_t e = hipLaunchCooperativeKernel((const void*)fwd_kernel, dim3(grid), dim3(512), args, LDS_BYTES, stream);
    if (e != hipSuccess) fprintf(stderr, "kernel_launch: cooperative launch failed: %s (grid %d)\n", hipGetErrorString(e), grid);
}
```
